# Optimizing an MI355X kernel written in HIP

```python
import math
import jax, jax.numpy as jnp
from jax import lax
import numpy as np

D_MODEL = 2048
BATCH = 4
SEQ = 4096
DEPTH = 1

MIX_WIDTH = D_MODEL
MLA_HEADS = 8
MLA_NOPE_DIM = 128
MLA_ROPE_DIM = 64
MLA_V_DIM = 128
MLA_QK_DIM = MLA_NOPE_DIM + MLA_ROPE_DIM
MLA_Q_RANK = D_MODEL // 4
MLA_KV_RANK = D_MODEL // 8
MLA_WIDTH = MLA_HEADS * MLA_V_DIM
ROPE_THETA = 10000.0
DIFF_WIDTH = MIX_WIDTH - MLA_WIDTH
DIFF_HEAD_DIM = 64
DIFF_HEADS = DIFF_WIDTH // (2 * DIFF_HEAD_DIM)

EPS = 1e-6
Q_BLOCK = 128

IN_SPLITS = [MLA_Q_RANK, MLA_KV_RANK, MLA_ROPE_DIM, MLA_WIDTH,
             DIFF_WIDTH, DIFF_WIDTH, DIFF_WIDTH, DIFF_WIDTH]
IN_WIDTH = sum(IN_SPLITS)
IN_SPLIT_IDX = [int(v) for v in np.cumsum(IN_SPLITS)[:-1]]

kernel_name = "hybrid_mla_diffattn_parallel_heads"


def rmsnorm(x, g):
    xf = x.astype(jnp.float32)
    y = xf * lax.rsqrt(jnp.mean(xf * xf, axis=-1, keepdims=True) + EPS)
    return (y * g.astype(jnp.float32)).astype(x.dtype)


def rope(t, pos):
    d = t.shape[-1]
    freqs = 1.0 / (ROPE_THETA ** (jnp.arange(0, d, 2, dtype=jnp.float32) / d))
    ang = pos.astype(jnp.float32)[:, None, :, None] * freqs
    cos, sin = jnp.cos(ang), jnp.sin(ang)
    tf = t.astype(jnp.float32)
    t1, t2 = tf[..., : d // 2], tf[..., d // 2:]
    return jnp.concatenate([t1 * cos - t2 * sin, t2 * cos + t1 * sin], axis=-1).astype(t.dtype)


def _to_blocks(t):
    b, h, s, d = t.shape
    return t.reshape(b, h, s // Q_BLOCK, Q_BLOCK, d).transpose(2, 0, 1, 3, 4)


def _from_blocks(t):
    nb, b, h, qb, d = t.shape
    return t.transpose(1, 0, 3, 2, 4).reshape(b, nb * qb, h, d)


def mla_attention(q, k, v):
    s_len = k.shape[2]
    scale = q.shape[-1] ** -0.5
    k_idx = jnp.arange(s_len)

    def step(args):
        qi, start = args
        s = jnp.einsum('bhqd,bhkd->bhqk', qi, k, preferred_element_type=jnp.float32) * scale
        causal = (start + jnp.arange(Q_BLOCK))[:, None] >= k_idx[None, :]
        s = jnp.where(causal, s, -jnp.inf)
        p = jax.nn.softmax(s, axis=-1)
        return jnp.einsum('bhqk,bhkd->bhqd', p.astype(v.dtype), v)

    starts = jnp.arange(s_len // Q_BLOCK) * Q_BLOCK
    return _from_blocks(lax.map(step, (_to_blocks(q), starts)))


def diff_attention(q1, q2, k1, k2, v, pos, lam):
    b, h, s_len, d = q1.shape
    scale = d ** -0.5
    k_idx = jnp.arange(s_len)
    slopes = 2.0 ** (-8.0 * (jnp.arange(h, dtype=jnp.float32) + 1.0) / h)
    pos_f = pos.astype(jnp.float32)
    pos_blocks = pos_f.reshape(b, s_len // Q_BLOCK, Q_BLOCK).transpose(1, 0, 2)

    def step(args):
        q1i, q2i, pi, start = args
        dist = jnp.abs(pi[:, None, :, None] - pos_f[:, None, None, :])
        bias = -slopes[None, :, None, None] * dist
        causal = (start + jnp.arange(Q_BLOCK))[:, None] >= k_idx[None, :]
        s1 = jnp.einsum('bhqd,bhkd->bhqk', q1i, k1, preferred_element_type=jnp.float32) * scale + bias
        s2 = jnp.einsum('bhqd,bhkd->bhqk', q2i, k2, preferred_element_type=jnp.float32) * scale + bias
        a = jax.nn.softmax(jnp.where(causal, s1, -jnp.inf), axis=-1) - lam * jax.nn.softmax(jnp.where(causal, s2, -jnp.inf), axis=-1)
        return jnp.einsum('bhqk,bhkd->bhqd', a.astype(v.dtype), v)

    starts = jnp.arange(s_len // Q_BLOCK) * Q_BLOCK
    return _from_blocks(lax.map(step, (_to_blocks(q1), _to_blocks(q2), pos_blocks, starts)))


def setup_inputs(seed: int = 0) -> dict:
    key = jax.random.key(seed)
    ks = jax.random.split(key, 16)
    f32 = jnp.float32

    def nrm(k, shape, fan_in):
        return jax.random.normal(k, shape, f32) * fan_in ** -0.5

    def gain(k, shape):
        return 1.0 + 0.05 * jax.random.normal(k, shape, f32)

    x = jax.random.normal(ks[0], (BATCH, SEQ, D_MODEL), f32)
    offs = jax.random.randint(ks[1], (BATCH, 1), 0, 1024, dtype=jnp.int32)
    positions = (jnp.arange(SEQ, dtype=jnp.int32)[None, :] + offs).astype(jnp.int32)
    return {
        "x": x,
        "positions": positions,
        "g_pre": gain(ks[2], (DEPTH, D_MODEL)),
        "w_in": nrm(ks[3], (DEPTH, D_MODEL, IN_WIDTH), D_MODEL),
        "g_q_a": gain(ks[4], (DEPTH, MLA_Q_RANK)),
        "w_q_b": nrm(ks[5], (DEPTH, MLA_Q_RANK, MLA_HEADS, MLA_QK_DIM), MLA_Q_RANK),
        "g_kv_a": gain(ks[6], (DEPTH, MLA_KV_RANK)),
        "w_kv_b": nrm(ks[7], (DEPTH, MLA_KV_RANK, MLA_HEADS, MLA_NOPE_DIM + MLA_V_DIM), MLA_KV_RANK),
        "lambda_q1": 0.1 * jax.random.normal(ks[8], (DEPTH, DIFF_HEAD_DIM), f32),
        "lambda_k1": 0.1 * jax.random.normal(ks[9], (DEPTH, DIFF_HEAD_DIM), f32),
        "lambda_q2": 0.1 * jax.random.normal(ks[10], (DEPTH, DIFF_HEAD_DIM), f32),
        "lambda_k2": 0.1 * jax.random.normal(ks[11], (DEPTH, DIFF_HEAD_DIM), f32),
        "g_diff_sub": gain(ks[12], (DEPTH, 2 * DIFF_HEAD_DIM)),
        "w_out": nrm(ks[13], (DEPTH, MIX_WIDTH, D_MODEL), MIX_WIDTH),
        "g_post": gain(ks[14], (DEPTH, D_MODEL)),
    }


def reference(x, positions, g_pre, w_in, g_q_a, w_q_b, g_kv_a, w_kv_b,
              lambda_q1, lambda_k1, lambda_q2, lambda_k2, g_diff_sub, w_out, g_post):
    b, s_len, _ = x.shape
    for l in range(DEPTH):
        h = rmsnorm(x, g_pre[l])
        proj = jnp.einsum('bsd,de->bse', h, w_in[l])
        q_lat, kv_lat, k_pe, gate_mla, dq, dk, dv, gate_diff = jnp.split(proj, IN_SPLIT_IDX, axis=-1)

        c_q = rmsnorm(q_lat, g_q_a[l])
        q = jnp.einsum('bsr,rhd->bhsd', c_q, w_q_b[l])
        q = jnp.concatenate([q[..., :MLA_NOPE_DIM], rope(q[..., MLA_NOPE_DIM:], positions)], axis=-1)
        c_kv = rmsnorm(kv_lat, g_kv_a[l])
        kv = jnp.einsum('bsr,rhd->bhsd', c_kv, w_kv_b[l])
        k_nope, v_mla = kv[..., :MLA_NOPE_DIM], kv[..., MLA_NOPE_DIM:]
        k_rot = rope(k_pe[:, None, :, :], positions)
        k = jnp.concatenate([k_nope, jnp.broadcast_to(k_rot, k_nope.shape[:-1] + (MLA_ROPE_DIM,))], axis=-1)
        o_mla = mla_attention(q, k, v_mla).reshape(b, s_len, MLA_WIDTH)

        dq = dq.reshape(b, s_len, DIFF_HEADS, 2, DIFF_HEAD_DIM).transpose(0, 2, 1, 3, 4)
        dk = dk.reshape(b, s_len, DIFF_HEADS, 2, DIFF_HEAD_DIM).transpose(0, 2, 1, 3, 4)
        dv = dv.reshape(b, s_len, DIFF_HEADS, 2 * DIFF_HEAD_DIM).transpose(0, 2, 1, 3)
        lam_init = 0.8 - 0.6 * math.exp(-0.3 * l)
        lam = (jnp.exp(jnp.sum(lambda_q1[l].astype(jnp.float32) * lambda_k1[l].astype(jnp.float32)))
               - jnp.exp(jnp.sum(lambda_q2[l].astype(jnp.float32) * lambda_k2[l].astype(jnp.float32)))
               + lam_init)
        o_diff = diff_attention(dq[..., 0, :], dq[..., 1, :], dk[..., 0, :], dk[..., 1, :], dv, positions, lam)
        o_diff = (rmsnorm(o_diff, g_diff_sub[l]) * (1.0 - lam_init)).reshape(b, s_len, DIFF_WIDTH)

        mixed = jnp.concatenate([o_mla * jax.nn.silu(gate_mla), o_diff * jax.nn.silu(gate_diff)], axis=-1)
        y = jnp.einsum('bse,ed->bsd', mixed, w_out[l])
        x = x + rmsnorm(y, g_post[l])
    return x
```

```cpp
#include <hip/hip_runtime.h>
#include <hip/hip_bf16.h>
#include <cstdio>
#include <cstdint>
#include <cmath>
namespace pg8 {
#define PG8_LAS __attribute__((address_space(3)))
typedef unsigned short bf16_t;
typedef short bf16x8 __attribute__((ext_vector_type(8)));
typedef float f32x4 __attribute__((ext_vector_type(4)));
typedef unsigned u32x4 __attribute__((ext_vector_type(4)));
constexpr int BM = 256, BK = 64, HALF = 128, HTB = HALF * BK * 2  , STAGE_BYTES = 8 * HTB, NXCD = 8, WGM = 8;

__host__ __device__ __forceinline__ int lds_byte(int r, int c) { const int st = (r >> 4) * 2 + (c >> 5), rr = r & 15, cc = c & 31, ob = rr * 64 + cc * 2; return st * 1024 + (ob ^ (((ob >> 9) & 1) << 5)); }
__host__ __device__ __forceinline__ void stage_rc(int b, int& R, int& C) { const int st = b / 1024, sb = b % 1024, swz = sb ^ (((sb >> 9) & 1) << 5); R = (st >> 1) * 16 + swz / 64; C = (st & 1) * 32 + (swz % 64) / 2; }
__host__ __device__ __forceinline__ int perm32(int rho) { const int n = rho >> 4, i = rho & 15; return 8 * (i >> 2) + 4 * n + (i & 3); }

struct Unit { int pm, pn; };
struct Gemm { const bf16_t* A; const bf16_t* Bt; int M, N, K; };

struct StaticOrder {
    int nM, nN, nwg, G, c;
    __host__ __device__ void init(int M, int N, int G_, int c_) { nM = M / BM; nN = N / BM; nwg = nM * nN; G = G_; c = c_; }
    __host__ __device__ bool next(int i, Unit& u) const {
        const long L = (long)i * G + c; if (L >= nwg) return false;
        int wgid = (int)L; { const int q = nwg / NXCD, r = nwg % NXCD, xcd = wgid % NXCD, off = wgid / NXCD; wgid = (xcd < r ? xcd * (q + 1) : r * (q + 1) + (xcd - r) * q) + off; }
        const int nig = WGM * nN, gid = wgid / nig, fm = gid * WGM, gsz = (nM - fm) < WGM ? (nM - fm) : WGM;
        u.pm = fm + ((wgid % nig) % gsz); u.pn = (wgid % nig) / gsz; return true;
    }
    __device__ __forceinline__ void a_ready(const Unit&) const {}
    __device__ __forceinline__ void done(const Unit&) const {}
};

__device__ __forceinline__ unsigned cvt_pk_bf16(float lo, float hi) { unsigned r; asm volatile("v_cvt_pk_bf16_f32 %0, %1, %2" : "=v"(r) : "v"(lo), "v"(hi)); return r; }
typedef float f32x2 __attribute__((ext_vector_type(2)));
constexpr float EPSN = 1e-6f;
constexpr float LOG2E = 1.4426950408889634f;
constexpr float QSCALE_MLA = 0.07216878364870322f * LOG2E;
constexpr float QSCALE_DIFF = 0.125f * LOG2E;
typedef unsigned u32x2 __attribute__((ext_vector_type(2)));
__device__ __forceinline__ u32x4 pack8(const f32x4 v0, const f32x4 v1) { u32x4 w; w.x = cvt_pk_bf16(v0[0], v0[1]); w.y = cvt_pk_bf16(v0[2], v0[3]); w.z = cvt_pk_bf16(v1[0], v1[1]); w.w = cvt_pk_bf16(v1[2], v1[3]); return w; }
__device__ __forceinline__ float silu_f(float x) { return x * __builtin_amdgcn_rcpf(1.0f + __builtin_amdgcn_exp2f(-x * LOG2E)); }
__device__ __forceinline__ f32x4 silu4(f32x4 v) { f32x4 o; o[0] = silu_f(v[0]); o[1] = silu_f(v[1]); o[2] = silu_f(v[2]); o[3] = silu_f(v[3]); return o; }
__device__ __forceinline__ void rope_store(const f32x4 v0, const f32x4 v1, const float* trig, int i0, bf16_t* dst_lo, bf16_t* dst_hi) {
    const f32x4 cs = *(const f32x4*)(trig + i0), sn = *(const f32x4*)(trig + 32 + i0);
    const f32x4 t1 = {v0[0], v0[2], v1[0], v1[2]}, t2 = {v0[1], v0[3], v1[1], v1[3]};
    const f32x4 o1 = t1 * cs - t2 * sn, o2 = t2 * cs + t1 * sn;
    u32x2 a, b; a.x = cvt_pk_bf16(o1[0], o1[1]); a.y = cvt_pk_bf16(o1[2], o1[3]); b.x = cvt_pk_bf16(o2[0], o2[1]); b.y = cvt_pk_bf16(o2[2], o2[3]);
    *(u32x2*)dst_lo = a; *(u32x2*)dst_hi = b;
}
struct EpiProj {
    static constexpr bool PERM = true, AFTER_DRAIN = false;
    bf16_t *QL, *KVL, *KR, *GM, *GD, *DQ, *DK, *DV; float* STATS; const float* TRIG;
    __device__ __forceinline__ void operator()(const f32x4 (&acc)[2][2][4][2], const Unit& u, int wr, int wc, int fr, int fq) const {
        const int pn = u.pn; const int row0 = u.pm * BM + wr * 64 + fr; const int cw = wc * 32 + 8 * fq;
        if (pn < 3) {
            bf16_t* base; int ld, ct, slot;
            if (pn < 2) { base = QL; ld = 512; ct = pn * 256; slot = pn * 4 + wc; } else { base = KVL; ld = 256; ct = 0; slot = 8 + wc; }
#pragma unroll
            for (int ai = 0; ai < 2; ++ai)
#pragma unroll
                for (int m = 0; m < 4; ++m) { const int row = row0 + ai * HALF + m * 16; float s = 0.f;
#pragma unroll
                    for (int bj = 0; bj < 2; ++bj) { const f32x4 v0 = acc[ai][bj][m][0], v1 = acc[ai][bj][m][1];
                        s += (v0[0] * v0[0] + v0[1] * v0[1]) + (v0[2] * v0[2] + v0[3] * v0[3]) + (v1[0] * v1[0] + v1[1] * v1[1]) + (v1[2] * v1[2] + v1[3] * v1[3]);
                        *(u32x4*)(base + (size_t)row * ld + ct + bj * HALF + cw) = pack8(v0, v1); }
                    s += __shfl_xor(s, 16); s += __shfl_xor(s, 32);
                    if (fq == 0) STATS[(size_t)row * 12 + slot] = s; }
        } else if (pn == 3) {
            if (wc < 2) { const int i0 = 16 * wc + 4 * fq;
#pragma unroll
                for (int ai = 0; ai < 2; ++ai)
#pragma unroll
                    for (int m = 0; m < 4; ++m) { const int row = row0 + ai * HALF + m * 16;
                        rope_store(acc[ai][0][m][0], acc[ai][0][m][1], TRIG + (size_t)row * 64, i0, KR + (size_t)row * 64 + i0, KR + (size_t)row * 64 + 32 + i0); } }
        } else {
            const int g = (pn - 4) >> 2; bf16_t* base = g == 0 ? GM : g == 1 ? DQ : g == 2 ? DK : g == 3 ? DV : GD; const int ct = ((pn - 4) & 3) * 256;
            const bool act = (g == 0 || g == 4); const float sc = (g == 1) ? QSCALE_DIFF : 1.0f;
#pragma unroll
            for (int ai = 0; ai < 2; ++ai)
#pragma unroll
                for (int m = 0; m < 4; ++m) { const int row = row0 + ai * HALF + m * 16;
#pragma unroll
                    for (int bj = 0; bj < 2; ++bj) { f32x4 v0 = acc[ai][bj][m][0], v1 = acc[ai][bj][m][1];
                        if (act) { v0 = silu4(v0); v1 = silu4(v1); } else { v0 = v0 * sc; v1 = v1 * sc; }
                        *(u32x4*)(base + (size_t)row * 1024 + ct + bj * HALF + cw) = pack8(v0, v1); } }
        }
    }
};
struct EpiQ {
    static constexpr bool PERM = true, AFTER_DRAIN = false;
    bf16_t* QM; const float* STATS; const float* TRIG;
    __device__ __forceinline__ void operator()(const f32x4 (&acc)[2][2][4][2], const Unit& u, int wr, int wc, int fr, int fq) const {
        const int row0 = u.pm * BM + wr * 64 + fr; const int cw = u.pn * BM + wc * 32 + 8 * fq;
#pragma unroll
        for (int ai = 0; ai < 2; ++ai)
#pragma unroll
            for (int m = 0; m < 4; ++m) { const int row = row0 + ai * HALF + m * 16;
                const f32x4 sa = *(const f32x4*)(STATS + (size_t)row * 12), sb = *(const f32x4*)(STATS + (size_t)row * 12 + 4);
                const float ss = ((sa[0] + sa[1]) + (sa[2] + sa[3])) + ((sb[0] + sb[1]) + (sb[2] + sb[3]));
                const float rs = QSCALE_MLA / sqrtf(ss * (1.0f / 512.0f) + EPSN);
#pragma unroll
                for (int bj = 0; bj < 2; ++bj) { const int c0 = cw + bj * HALF; const int h = c0 / 192, d = c0 - h * 192;
                    const f32x4 v0 = acc[ai][bj][m][0] * rs, v1 = acc[ai][bj][m][1] * rs;
                    if (d < 128) *(u32x4*)(QM + (size_t)row * 1536 + c0) = pack8(v0, v1);
                    else { const int i0 = (d - 128) >> 1; bf16_t* q = QM + (size_t)row * 1536 + h * 192 + 128 + i0; rope_store(v0, v1, TRIG + (size_t)row * 64, i0, q, q + 32); } } }
    }
};
struct EpiKV {
    static constexpr bool PERM = true, AFTER_DRAIN = false;
    bf16_t* KVM; const float* STATS;
    __device__ __forceinline__ void operator()(const f32x4 (&acc)[2][2][4][2], const Unit& u, int wr, int wc, int fr, int fq) const {
        const int row0 = u.pm * BM + wr * 64 + fr; const int cw = u.pn * BM + wc * 32 + 8 * fq;
#pragma unroll
        for (int ai = 0; ai < 2; ++ai)
#pragma unroll
            for (int m = 0; m < 4; ++m) { const int row = row0 + ai * HALF + m * 16;
                const f32x4 sa = *(const f32x4*)(STATS + (size_t)row * 12 + 8);
                const float ss = (sa[0] + sa[1]) + (sa[2] + sa[3]);
                const float rs = 1.0f / sqrtf(ss * (1.0f / 256.0f) + EPSN);
#pragma unroll
                for (int bj = 0; bj < 2; ++bj) *(u32x4*)(KVM + (size_t)row * 2048 + cw + bj * HALF) = pack8(acc[ai][bj][m][0] * rs, acc[ai][bj][m][1] * rs); }
    }
};
struct EpiY {
    static constexpr bool PERM = false, AFTER_DRAIN = false;
    float* Y; float* YSTAT;
    __device__ __forceinline__ void operator()(const f32x4 (&acc)[2][2][4][2], const Unit& u, int wr, int wc, int fr, int fq) const {
        const int row0 = u.pm * BM + wr * 64 + fr; const int col0 = u.pn * BM + wc * 32 + 4 * fq;
#pragma unroll
        for (int ai = 0; ai < 2; ++ai)
#pragma unroll
            for (int m = 0; m < 4; ++m) { const int row = row0 + ai * HALF + m * 16; float s = 0.f;
#pragma unroll
                for (int bj = 0; bj < 2; ++bj)
#pragma unroll
                    for (int n = 0; n < 2; ++n) { const f32x4 v = acc[ai][bj][m][n]; s += (v[0] * v[0] + v[1] * v[1]) + (v[2] * v[2] + v[3] * v[3]);
                        *(f32x4*)(Y + (size_t)row * 2048 + col0 + bj * HALF + n * 16) = v; }
                s += __shfl_xor(s, 16); s += __shfl_xor(s, 32);
                if (fq == 0) YSTAT[(size_t)row * 32 + u.pn * 4 + wc] = s; }
    }
};

template <class Epi, class Sched, bool ALIGN_EPI = false, bool SP2 = false>
__device__ __forceinline__ void gemm_phase(PG8_LAS unsigned char* lds, const Gemm g, const Sched& S, const Epi& E) {
    const int tid = threadIdx.x, wid = __builtin_amdgcn_readfirstlane(tid >> 6), lane = tid & 63, wr = wid >> 2, wc = wid & 3, fr = lane & 15, fq = lane >> 4;
    const int K = g.K, nt = K / BK;
    unsigned voffA[2], voffB[2];
#pragma unroll
    for (int i = 0; i < 2; ++i) { int R, C; stage_rc(tid * 16 + i * 8192, R, C); const int Rb = Epi::PERM ? ((R & ~31) + perm32(R & 31)) : R;
        voffA[i] = (unsigned)(R * K + C) * 2u; voffB[i] = (unsigned)(Rb * K + C) * 2u; }
    const size_t kstep = (size_t)(BK * 2);
    const size_t hstep = (size_t)HALF * K * 2;
    const size_t tstep = 2 * hstep;
    const unsigned ldsw = (unsigned)wid * 1024u;
    const int aoff = lds_byte(wr * 64 + fr, fq * 8), boff = lds_byte(wc * 32 + fr, fq * 8);
#define PG8_SA(b, h) (((b) * 2 + (h)) * HTB)
#define PG8_SB(b, h) ((4 + (b) * 2 + (h)) * HTB)
#define PG8_STAGE(bufoff, gbase, voff) do { _Pragma("unroll") for (int _i = 0; _i < 2; ++_i) \
        __builtin_amdgcn_global_load_lds((const unsigned*)((const char*)(gbase) + (voff)[_i]), (PG8_LAS unsigned*)(lds + (bufoff) + ldsw + _i * 8192), 16, 0, 0); } while (0)
#define PG8_LDA(dst, b, h) do { _Pragma("unroll") for (int m = 0; m < 4; ++m) _Pragma("unroll") for (int k = 0; k < 2; ++k) dst[m][k] = *(const PG8_LAS bf16x8*)(lds + PG8_SA(b, h) + aoff + m * 2048 + k * 1024); } while (0)
#define PG8_LDB(dst, b, h) do { _Pragma("unroll") for (int n = 0; n < 2; ++n) _Pragma("unroll") for (int k = 0; k < 2; ++k) dst[n][k] = *(const PG8_LAS bf16x8*)(lds + PG8_SB(b, h) + boff + n * 2048 + k * 1024); } while (0)
#define PG8_MMA(ai, bj, At, Bt) do { __builtin_amdgcn_s_setprio(1); _Pragma("unroll") for (int m = 0; m < 4; ++m) _Pragma("unroll") for (int n = 0; n < 2; ++n) _Pragma("unroll") for (int k = 0; k < 2; ++k) \
        acc[ai][bj][m][n] = __builtin_amdgcn_mfma_f32_16x16x32_bf16(Bt[n][k], At[m][k], acc[ai][bj][m][n], 0, 0, 0); __builtin_amdgcn_s_setprio(0); } while (0)
#define PG8_WAIT_V(n) asm volatile("s_waitcnt vmcnt(" #n ")" ::: "memory")
#define PG8_WAIT_L(n) asm volatile("s_waitcnt lgkmcnt(" #n ")" ::: "memory")
#define PG8_BAR __builtin_amdgcn_s_barrier()
#define PG8_SCHED __builtin_amdgcn_sched_barrier(0)
    Unit cur, nxt; int ui = 0;
    if (!S.next(0, cur)) return;
    f32x4 acc[2][2][4][2];
#pragma unroll
    for (int a = 0; a < 2; ++a)
#pragma unroll
        for (int b = 0; b < 2; ++b)
#pragma unroll
            for (int m = 0; m < 4; ++m)
#pragma unroll
                for (int n = 0; n < 2; ++n) acc[a][b][m][n] = (f32x4){0.f, 0.f, 0.f, 0.f};
    bf16x8 At[4][2], B0[2][2], B1[2][2];
    const char* cA = (const char*)g.A + (size_t)cur.pm * tstep; const char* cB = (const char*)g.Bt + (size_t)cur.pn * tstep;
    S.a_ready(cur);
    if constexpr (SP2) {
        PG8_STAGE(PG8_SB(0, 0), cB, voffB); PG8_STAGE(PG8_SB(0, 1), cB + hstep, voffB); PG8_STAGE(PG8_SA(0, 0), cA, voffA); PG8_STAGE(PG8_SA(0, 1), cA + hstep, voffA);
        if (wr == 1) PG8_BAR;
        PG8_WAIT_V(2); PG8_BAR;
        PG8_STAGE(PG8_SB(1, 0), cB + kstep, voffB); PG8_STAGE(PG8_SA(1, 0), cA + kstep, voffA); PG8_STAGE(PG8_SB(1, 1), cB + hstep + kstep, voffB);
        PG8_WAIT_V(6); PG8_BAR;
    } else {
        PG8_STAGE(PG8_SB(0, 0), cB, voffB); PG8_STAGE(PG8_SA(0, 0), cA, voffA); PG8_STAGE(PG8_SB(0, 1), cB + hstep, voffB); PG8_STAGE(PG8_SA(0, 1), cA + hstep, voffA);
        if (wr == 1) PG8_BAR;
        PG8_WAIT_V(4); PG8_BAR;
        PG8_STAGE(PG8_SB(1, 0), cB + kstep, voffB); PG8_STAGE(PG8_SA(1, 0), cA + kstep, voffA); PG8_STAGE(PG8_SB(1, 1), cB + hstep + kstep, voffB);
        PG8_WAIT_V(6); PG8_BAR;
    }
    for (;;) {
        const bool has_next = S.next(ui + 1, nxt);
        const char* nA = has_next ? (const char*)g.A + (size_t)nxt.pm * tstep : cA; const char* nB = has_next ? (const char*)g.Bt + (size_t)nxt.pn * tstep : cB;
        for (int t = 0; t < nt; t += 2) {
            const bool last = (t == nt - 2);
            const char* a1 = cA + (size_t)(t + 1) * kstep;
            const char* a2 = last ? nA : cA + (size_t)(t + 2) * kstep; const char* b2 = last ? nB : cB + (size_t)(t + 2) * kstep;
            const char* a3 = a2 + kstep; const char* b3 = b2 + kstep;
            if (last && has_next) S.a_ready(nxt);
            if constexpr (SP2) {
            PG8_LDB(B0, 0, 0); PG8_LDB(B1, 0, 1); PG8_SCHED; PG8_LDA(At, 0, 0); PG8_STAGE(PG8_SA(1, 1), a1 + hstep, voffA);
            PG8_WAIT_V(8); PG8_WAIT_L(0); PG8_BAR; PG8_MMA(0, 0, At, B0); PG8_MMA(0, 1, At, B1); PG8_BAR; PG8_SCHED;
            PG8_LDA(At, 0, 1); PG8_STAGE(PG8_SB(0, 0), b2, voffB); PG8_STAGE(PG8_SB(0, 1), b2 + hstep, voffB); PG8_STAGE(PG8_SA(0, 0), a2, voffA);
            PG8_WAIT_V(8); PG8_WAIT_L(0); PG8_BAR; PG8_MMA(1, 0, At, B0); PG8_MMA(1, 1, At, B1); PG8_BAR; PG8_SCHED;
            PG8_LDB(B0, 1, 0); PG8_LDB(B1, 1, 1); PG8_SCHED; PG8_LDA(At, 1, 0); PG8_STAGE(PG8_SA(0, 1), a2 + hstep, voffA);
            PG8_WAIT_V(8); PG8_WAIT_L(0); PG8_BAR; PG8_MMA(0, 0, At, B0); PG8_MMA(0, 1, At, B1); PG8_BAR; PG8_SCHED;
            PG8_LDA(At, 1, 1); PG8_STAGE(PG8_SB(1, 0), b3, voffB); PG8_STAGE(PG8_SB(1, 1), b3 + hstep, voffB); PG8_STAGE(PG8_SA(1, 0), a3, voffA);
            PG8_WAIT_V(8); PG8_WAIT_L(0); PG8_BAR; PG8_MMA(1, 0, At, B0); PG8_MMA(1, 1, At, B1); PG8_BAR; PG8_SCHED;
            } else {
            PG8_LDB(B0, 0, 0); PG8_SCHED; PG8_LDA(At, 0, 0); PG8_STAGE(PG8_SA(1, 1), a1 + hstep, voffA);
            PG8_WAIT_L(8); PG8_BAR; PG8_WAIT_L(0); PG8_MMA(0, 0, At, B0); PG8_BAR; PG8_SCHED;
            PG8_LDB(B1, 0, 1); PG8_STAGE(PG8_SB(0, 0), b2, voffB);
            PG8_BAR; PG8_WAIT_L(0); PG8_MMA(0, 1, At, B1); PG8_BAR;
            PG8_LDA(At, 0, 1); PG8_STAGE(PG8_SA(0, 0), a2, voffA);
            PG8_BAR; PG8_WAIT_L(0); PG8_MMA(1, 0, At, B0); PG8_BAR; PG8_SCHED;
            PG8_STAGE(PG8_SB(0, 1), b2 + hstep, voffB);
            PG8_WAIT_V(6); PG8_BAR; PG8_MMA(1, 1, At, B1); PG8_BAR;
            PG8_LDB(B0, 1, 0); PG8_SCHED; PG8_LDA(At, 1, 0); PG8_STAGE(PG8_SA(0, 1), a2 + hstep, voffA);
            PG8_WAIT_L(8); PG8_BAR; PG8_WAIT_L(0); PG8_MMA(0, 0, At, B0); PG8_BAR; PG8_SCHED;
            PG8_LDB(B1, 1, 1); PG8_STAGE(PG8_SB(1, 0), b3, voffB);
            PG8_BAR; PG8_WAIT_L(0); PG8_MMA(0, 1, At, B1); PG8_BAR;
            PG8_LDA(At, 1, 1); PG8_STAGE(PG8_SA(1, 0), a3, voffA);
            PG8_BAR; PG8_WAIT_L(0); PG8_MMA(1, 0, At, B0); PG8_BAR; PG8_SCHED;
            PG8_STAGE(PG8_SB(1, 1), b3 + hstep, voffB);
            PG8_WAIT_V(6); PG8_BAR; PG8_MMA(1, 1, At, B1); PG8_BAR;
            }
        }
        if constexpr (ALIGN_EPI) { if (wr == 0) PG8_BAR; }
        if constexpr (!Epi::AFTER_DRAIN) { E(acc, cur, wr, wc, fr, fq); S.done(cur); }
        if (!has_next) break;
#pragma unroll
        for (int a = 0; a < 2; ++a)
#pragma unroll
            for (int b = 0; b < 2; ++b)
#pragma unroll
                for (int m = 0; m < 4; ++m)
#pragma unroll
                    for (int n = 0; n < 2; ++n) acc[a][b][m][n] = (f32x4){0.f, 0.f, 0.f, 0.f};
        cur = nxt; cA = nA; cB = nB; ++ui;
        if constexpr (ALIGN_EPI) { if (wr == 1) PG8_BAR; }
    }
    PG8_WAIT_V(0);
    if constexpr (!ALIGN_EPI) { if (wr == 0) PG8_BAR; }
    PG8_BAR;
    if constexpr (Epi::AFTER_DRAIN) { E.fused(acc, cur, wr, wc, fr, fq, lds, wid, lane); S.done(cur); }
#undef PG8_SA
#undef PG8_SB
#undef PG8_STAGE
#undef PG8_LDA
#undef PG8_LDB
#undef PG8_MMA
#undef PG8_WAIT_V
#undef PG8_WAIT_L
#undef PG8_BAR
#undef PG8_SCHED
}
}
namespace att {
#define ALAS __attribute__((address_space(3)))
using bf16 = unsigned short;
using bf16x8 = __attribute__((ext_vector_type(8))) short;
using s16x4  = __attribute__((ext_vector_type(4))) short;
using f32x16 = __attribute__((ext_vector_type(16))) float;
using f32x4  = __attribute__((ext_vector_type(4))) float;
using u32x4  = __attribute__((ext_vector_type(4))) unsigned;
constexpr int SEQ = 4096, NW = 8, QBLK = 32, KVBLK = 64;
constexpr float THR = 8.f;
constexpr float LOG2E = 1.4426950408889634f;
constexpr int BUF_BYTES = 40960, K_OFF = 0, KR_OFF = 16384, V_OFF = 24576;
constexpr int WS_OFF = 2 * BUF_BYTES, POSK_OFF = WS_OFF + NW * 256, ATT_LDS_BYTES = POSK_OFF + SEQ * 4;
#define SBAR() __builtin_amdgcn_sched_barrier(0)
__device__ __forceinline__ int crow(int r, int hi) { return (r & 3) + 8 * (r >> 2) + 4 * hi; }
__device__ __forceinline__ unsigned cvtpk(float lo, float hi) { unsigned r; asm volatile("v_cvt_pk_bf16_f32 %0, %1, %2" : "=v"(r) : "v"(lo), "v"(hi)); return r; }
__device__ __forceinline__ int opq(int x) { asm volatile("" : "+v"(x)); return x; }
__device__ __forceinline__ float bf2f(bf16 v) { return __uint_as_float((unsigned)v << 16); }
__device__ __forceinline__ bf16 f2bf(float f) { unsigned u = __float_as_uint(f); return (bf16)((u + 0x7fffu + ((u >> 16) & 1u)) >> 16); }
__device__ __forceinline__ void glds16(const void* g, ALAS char* l) { __builtin_amdgcn_global_load_lds((const unsigned*)g, (ALAS unsigned*)l, 16, 0, 0); }

__device__ __forceinline__ void dma_k256(const bf16* src, int ld, ALAS char* dst, int wid, int lane) {
#pragma unroll
  for (int i = 0; i < 2; ++i) { const int piece = i * 8 + wid, row = piece * 4 + (lane >> 4), c = (lane & 15) ^ (row & 7);
    glds16(src + (size_t)row * ld + c * 8, dst + piece * 1024); }
}
__device__ __forceinline__ void dma_k128(const bf16* src, int ld, ALAS char* dst, int wid, int lane) {
  const int row = wid * 8 + (lane >> 3), c = (lane & 7) ^ ((row >> 1) & 7);
  glds16(src + (size_t)row * ld + c * 8, dst + wid * 1024);
}
__device__ __forceinline__ void dma_v(const bf16* src, int ld, ALAS char* dst, int wid, int lane) {
#pragma unroll
  for (int i = 0; i < 2; ++i) { const int piece = i * 8 + wid, p = piece * 64 + lane, sub = p >> 5, kk = (sub >> 2) * 8 + ((p & 31) >> 2);
    const int k = (kk & ~0xC) | ((kk & 4) << 1) | ((kk & 8) >> 1), col = (sub & 3) * 32 + (p & 3) * 8;
    glds16(src + (size_t)k * ld + col, dst + piece * 1024); }
}
__device__ __forceinline__ int v_rd_base(int lane) { return ((lane & 3) << 3) | (((lane >> 2) & 3) << 6) | (((lane >> 4) & 1) << 5) | (((lane >> 5) & 1) << 8); }
constexpr int v_rd_off(int d0, int ks, int half) { return d0 * 512 + ks * 4096 + half * 2048; }
template <int OFF> __device__ __forceinline__ s16x4 tr_read(int vb) { s16x4 r; asm volatile("ds_read_b64_tr_b16 %0, %1 offset:%2" : "=&v"(r) : "v"(vb), "i"(OFF) : "memory"); return r; }
template <int D0> __device__ __forceinline__ void pv_one(f32x16& od, int vb, bf16x8 pa0, bf16x8 pa1, bf16x8 pa2, bf16x8 pa3) {
  const s16x4 l0 = tr_read<v_rd_off(D0, 0, 0)>(vb), h0 = tr_read<v_rd_off(D0, 0, 1)>(vb), l1 = tr_read<v_rd_off(D0, 1, 0)>(vb), h1 = tr_read<v_rd_off(D0, 1, 1)>(vb);
  const s16x4 l2 = tr_read<v_rd_off(D0, 2, 0)>(vb), h2 = tr_read<v_rd_off(D0, 2, 1)>(vb), l3 = tr_read<v_rd_off(D0, 3, 0)>(vb), h3 = tr_read<v_rd_off(D0, 3, 1)>(vb);
  asm volatile("s_waitcnt lgkmcnt(0)" ::: "memory"); SBAR();
#define PK(L, H) (bf16x8){L[0], L[1], L[2], L[3], H[0], H[1], H[2], H[3]}
  od = __builtin_amdgcn_mfma_f32_32x32x16_bf16(pa0, PK(l0, h0), od, 0, 0, 0);
  od = __builtin_amdgcn_mfma_f32_32x32x16_bf16(pa1, PK(l1, h1), od, 0, 0, 0);
  od = __builtin_amdgcn_mfma_f32_32x32x16_bf16(pa2, PK(l2, h2), od, 0, 0, 0);
  od = __builtin_amdgcn_mfma_f32_32x32x16_bf16(pa3, PK(l3, h3), od, 0, 0, 0);
#undef PK
}
__device__ __forceinline__ void pv_d0(f32x16* o, int vb, bf16x8 pa0, bf16x8 pa1, bf16x8 pa2, bf16x8 pa3) {
  pv_one<0>(o[0], vb, pa0, pa1, pa2, pa3); pv_one<1>(o[1], vb, pa0, pa1, pa2, pa3); pv_one<2>(o[2], vb, pa0, pa1, pa2, pa3); pv_one<3>(o[3], vb, pa0, pa1, pa2, pa3);
}
__device__ __forceinline__ void partialSM(f32x16& p0, f32x16& p1, float& m_reg, float& alpha) {
  float pmax = p0[0];
#pragma unroll
  for (int r = 1; r < 16; ++r) pmax = fmaxf(pmax, p0[r]);
#pragma unroll
  for (int r = 0; r < 16; ++r) pmax = fmaxf(pmax, p1[r]);
  { auto rr = __builtin_amdgcn_permlane32_swap(__float_as_uint(pmax), __float_as_uint(pmax), false, false); pmax = fmaxf(__uint_as_float(rr[0]), __uint_as_float(rr[1])); }
  float mn;
  if (__builtin_expect(__all(pmax - m_reg <= THR), 1)) { mn = m_reg; alpha = 1.f; }
  else { mn = fmaxf(m_reg, pmax); alpha = __builtin_amdgcn_exp2f(m_reg - mn); m_reg = mn; }
#pragma unroll
  for (int r = 0; r < 16; ++r) p0[r] = __builtin_amdgcn_exp2f(p0[r] - mn);
#pragma unroll
  for (int r = 0; r < 16; ++r) p1[r] = __builtin_amdgcn_exp2f(p1[r] - mn);
}
__device__ __forceinline__ void finishSM(f32x16& p0, f32x16& p1, float alpha, float& l_reg, bf16x8& pa0, bf16x8& pa1, bf16x8& pa2, bf16x8& pa3) {
  float ps = 0.f;
#pragma unroll
  for (int r = 0; r < 16; ++r) ps += p0[r];
#pragma unroll
  for (int r = 0; r < 16; ++r) ps += p1[r];
  { auto rr = __builtin_amdgcn_permlane32_swap(__float_as_uint(ps), __float_as_uint(ps), false, false); ps = __uint_as_float(rr[0]) + __uint_as_float(rr[1]); }
  l_reg = l_reg * alpha + ps;
#define PK4(P, BASE, OUT) do { unsigned a0 = cvtpk(P[BASE + 0], P[BASE + 1]), a1 = cvtpk(P[BASE + 2], P[BASE + 3]);   \
    unsigned b0 = cvtpk(P[BASE + 4], P[BASE + 5]), b1 = cvtpk(P[BASE + 6], P[BASE + 7]);                              \
    auto r0 = __builtin_amdgcn_permlane32_swap(a0, b0, false, false); auto r1 = __builtin_amdgcn_permlane32_swap(a1, b1, false, false); \
    u32x4 w = {r0[0], r1[0], r0[1], r1[1]}; OUT = *reinterpret_cast<bf16x8*>(&w); } while (0)
  PK4(p0, 0, pa0); PK4(p0, 8, pa1); PK4(p1, 0, pa2); PK4(p1, 8, pa3);
#undef PK4
}
__device__ __forceinline__ void mask_tile(f32x16& p0, f32x16& p1, int qrel, int hi) {
  hi = opq(hi); qrel = opq(qrel);
#pragma unroll
  for (int r = 0; r < 16; ++r) { const int kv = crow(r, hi); if (kv > qrel) p0[r] = -INFINITY; if (kv + 32 > qrel) p1[r] = -INFINITY; }
}
struct Ptrs { const bf16 *QM, *KVM, *KR, *DQ, *DK, *DV, *GM, *GD; bf16* MIX; const int* pos; const float* gsub; };

#define ATT_RESC(O, a) do { if (__any((a) < 1.f)) { if (hi == 0) wsf[r32] = (a); asm volatile("s_waitcnt lgkmcnt(0)" ::: "memory"); \
    _Pragma("unroll") for (int d = 0; d < 4; ++d) _Pragma("unroll") for (int r = 0; r < 16; ++r) O[d][r] *= wsf[crow(r, hi)]; } } while (0)

template <bool MLA>
__device__ __forceinline__ void tile_loop(f32x16 (&o)[4], float& l_reg, const bf16x8* qr, const bf16* K256, int ldk256, const bf16* K128, int ldk128, const bf16* Vsrc, int ldv,
                                          ALAS char* lds, int NT, int td, int qlo, float pq, float ch, int wid, int lane) {
  const int r32 = lane & 31, hi = lane >> 5;
  ALAS float* wsf = (ALAS float*)(lds + WS_OFF) + wid * 64; ALAS float* posk = (ALAS float*)(lds + POSK_OFF);
#define TL_DMA(t, bufo) do { if (MLA) dma_k256(K256 + (size_t)(t) * KVBLK * ldk256, ldk256, lds + (bufo) + K_OFF, wid, lane); \
    dma_k128(K128 + (size_t)(t) * KVBLK * ldk128, ldk128, lds + (bufo) + KR_OFF, wid, lane); dma_v(Vsrc + (size_t)(t) * KVBLK * ldv, ldv, lds + (bufo) + V_OFF, wid, lane); } while (0)
  TL_DMA(0, 0);
  float m_reg = -1e30f; l_reg = 0.f;
#pragma unroll
  for (int d = 0; d < 4; ++d) o[d] = f32x16{};
  const int vb0 = (int)(uintptr_t)(lds + V_OFF) + v_rd_base(lane);
  const int ka = r32 * 256, ksw = (r32 & 7), kra = r32 * 128, krsw = (r32 >> 1) & 7;
  asm volatile("s_waitcnt vmcnt(0)" ::: "memory"); __syncthreads();
  for (int t = 0; t < NT; ++t) {
    const int bufo = (t & 1) * BUF_BYTES;
    if (t + 1 < NT) TL_DMA(t + 1, BUF_BYTES - bufo);
    if (t <= td) {
      f32x16 p0 = {}, p1 = {};
      const ALAS char* Kb = lds + bufo + K_OFF; const ALAS char* Kr = lds + bufo + KR_OFF;
      if (!MLA) {
#pragma unroll
        for (int g = 0; g < 4; ++g) { const f32x4 a = *reinterpret_cast<const ALAS f32x4*>(posk + t * KVBLK + 8 * g + 4 * hi), c = *reinterpret_cast<const ALAS f32x4*>(posk + t * KVBLK + 32 + 8 * g + 4 * hi);
#pragma unroll
          for (int j = 0; j < 4; ++j) { p0[4 * g + j] = -ch * fabsf(pq - a[j]); p1[4 * g + j] = -ch * fabsf(pq - c[j]); } }
      }
      if (MLA) {
#pragma unroll
        for (int d0 = 0; d0 < 8; ++d0) { const int off = ka + (((2 * d0 + hi) ^ ksw) << 4);
          const bf16x8 b0 = *reinterpret_cast<const ALAS bf16x8*>(Kb + off), b1 = *reinterpret_cast<const ALAS bf16x8*>(Kb + off + 32 * 256);
          p0 = __builtin_amdgcn_mfma_f32_32x32x16_bf16(b0, qr[d0], p0, 0, 0, 0); p1 = __builtin_amdgcn_mfma_f32_32x32x16_bf16(b1, qr[d0], p1, 0, 0, 0); }
      }
#pragma unroll
      for (int d0 = 0; d0 < 4; ++d0) { const int off = kra + (((2 * d0 + hi) ^ krsw) << 4);
        const bf16x8 b0 = *reinterpret_cast<const ALAS bf16x8*>(Kr + off), b1 = *reinterpret_cast<const ALAS bf16x8*>(Kr + off + 32 * 128);
        p0 = __builtin_amdgcn_mfma_f32_32x32x16_bf16(b0, qr[(MLA ? 8 : 0) + d0], p0, 0, 0, 0); p1 = __builtin_amdgcn_mfma_f32_32x32x16_bf16(b1, qr[(MLA ? 8 : 0) + d0], p1, 0, 0, 0); }
      if (t == td) mask_tile(p0, p1, qlo + r32 - t * KVBLK, hi);
      float alpha; bf16x8 pa0, pa1, pa2, pa3;
      partialSM(p0, p1, m_reg, alpha); ATT_RESC(o, alpha); finishSM(p0, p1, alpha, l_reg, pa0, pa1, pa2, pa3); SBAR();
      pv_d0(o, vb0 + bufo, pa0, pa1, pa2, pa3);
    }
    asm volatile("s_waitcnt vmcnt(0)" ::: "memory"); __syncthreads();
  }
#undef TL_DMA
}

__device__ __forceinline__ void mla_unit(const Ptrs& P, int b, int h, int qb, ALAS char* lds) {
  const int tid = threadIdx.x, lane = tid & 63, r32 = lane & 31, hi = lane >> 5; const int wid = __builtin_amdgcn_readfirstlane(tid >> 6);
  const size_t rowbase = (size_t)b * SEQ; const int q0 = qb * 256, qlo = q0 + wid * QBLK, NT = 4 * (qb + 1), td = qlo >> 6;
  const bf16* Ksrc = P.KVM + rowbase * 2048 + h * 256; const bf16* Vsrc = Ksrc + 128; const bf16* KRsrc = P.KR + rowbase * 64;
  ALAS float* wsf = (ALAS float*)(lds + WS_OFF) + wid * 64;
  bf16x8 qr[12];
  { const bf16* Qw = P.QM + (rowbase + qlo + r32) * 1536 + h * 192 + hi * 8;
#pragma unroll
    for (int d0 = 0; d0 < 12; ++d0) qr[d0] = *reinterpret_cast<const bf16x8*>(Qw + d0 * 16); }
  f32x16 o[4]; float l_reg;
  tile_loop<true>(o, l_reg, qr, Ksrc, 2048, KRsrc, 64, Vsrc, 2048, lds, NT, td, qlo, 0.f, 0.f, wid, lane);
  { const int hi2 = opq(hi), rr = opq(r32);
    if (hi2 == 0) wsf[32 + rr] = l_reg; asm volatile("s_waitcnt lgkmcnt(0)" ::: "memory");
    const size_t rb = rowbase + qlo + 4 * hi2; const int cb = h * 128 + rr;
#pragma unroll
    for (int r = 0; r < 16; ++r) { const int cr = (r & 3) + 8 * (r >> 2); const float rli = __builtin_amdgcn_rcpf(wsf[32 + 4 * hi2 + cr]); const size_t row = rb + cr;
#pragma unroll
      for (int d0 = 0; d0 < 4; ++d0) { const int col = cb + d0 * 32; const float g = bf2f(P.GM[row * 1024 + col]); P.MIX[row * 2048 + col] = f2bf(o[d0][r] * rli * g); }
      if (r & 1) asm volatile("" ::: "memory"); } }
  asm volatile("s_waitcnt lgkmcnt(0)" ::: "memory");
}

__device__ __forceinline__ void diff_unit(const Ptrs& P, int b, int h, int qb, ALAS char* lds, float lam, float* park) {
  const int tid = threadIdx.x, lane = tid & 63, r32 = lane & 31, hi = lane >> 5; const int wid = __builtin_amdgcn_readfirstlane(tid >> 6);
  const size_t rowbase = (size_t)b * SEQ; const int q0 = qb * 256, qlo = q0 + wid * QBLK, NT = 4 * (qb + 1), td = qlo >> 6;
  const bf16* Ksrc = P.DK + rowbase * 1024 + h * 128; const bf16* Vsrc = P.DV + rowbase * 1024 + h * 128;
  ALAS float* wsf = (ALAS float*)(lds + WS_OFF) + wid * 64; ALAS float* posk = (ALAS float*)(lds + POSK_OFF);
  for (int i = tid; i < q0 + 256; i += NW * 64) posk[i] = (float)P.pos[rowbase + i];
  const float pq = (float)P.pos[rowbase + qlo + r32];
  const float ch = __builtin_amdgcn_exp2f(-(float)(h + 1)) * LOG2E;
#pragma unroll 1
  for (int mp = 0; mp < 2; ++mp) {
    bf16x8 qr[4];
    { const bf16* Qw = P.DQ + (rowbase + qlo + r32) * 1024 + h * 128 + mp * 64 + hi * 8;
#pragma unroll
      for (int d0 = 0; d0 < 4; ++d0) qr[d0] = *reinterpret_cast<const bf16x8*>(Qw + d0 * 16); }
    f32x16 o[4]; float l_reg;
    tile_loop<false>(o, l_reg, qr, nullptr, 0, Ksrc + mp * 64, 1024, Vsrc, 1024, lds, NT, td, qlo, pq, ch, wid, lane);
    const int hi2 = opq(hi), rr = opq(r32), ln = opq(lane);
    if (hi2 == 0) wsf[32 + rr] = l_reg; asm volatile("s_waitcnt lgkmcnt(0)" ::: "memory");
    if (mp == 0) {
#pragma unroll
      for (int r = 0; r < 16; ++r) { const int cr = (r & 3) + 8 * (r >> 2); const float rli = __builtin_amdgcn_rcpf(wsf[32 + 4 * hi2 + cr]);
#pragma unroll
        for (int d0 = 0; d0 < 4; ++d0) { float* pd = park + d0 * 1024 + ln; pd[r * 64] = o[d0][r] * rli; } }
    } else {
      float gs[4];
#pragma unroll
      for (int d0 = 0; d0 < 4; ++d0) gs[d0] = P.gsub[d0 * 32 + rr] * 0.8f;
      const size_t rb = rowbase + qlo + 4 * hi2; const int cb = h * 128 + rr;
#pragma unroll
      for (int r = 0; r < 16; ++r) { const int cr = (r & 3) + 8 * (r >> 2); const float r2 = lam * __builtin_amdgcn_rcpf(wsf[32 + 4 * hi2 + cr]); const size_t row = rb + cr;
        float v[4], ss = 0.f;
#pragma unroll
        for (int d0 = 0; d0 < 4; ++d0) { const float* pd = park + d0 * 1024 + ln; v[d0] = pd[r * 64] - o[d0][r] * r2; ss += v[d0] * v[d0]; }
        ss += __shfl_xor(ss, 1); ss += __shfl_xor(ss, 2); ss += __shfl_xor(ss, 4); ss += __shfl_xor(ss, 8); ss += __shfl_xor(ss, 16);
        const float rn = 1.0f / sqrtf(ss * (1.0f / 128.0f) + 1e-6f);
#pragma unroll
        for (int d0 = 0; d0 < 4; ++d0) { const int col = cb + d0 * 32; const float g = bf2f(P.GD[row * 1024 + col]); P.MIX[row * 2048 + 1024 + col] = f2bf(v[d0] * rn * gs[d0] * g); }
        if (r & 1) asm volatile("" ::: "memory"); }
    }
    asm volatile("s_waitcnt vmcnt(0) lgkmcnt(0)" ::: "memory");
  }
}
#undef ATT_RESC
#undef SBAR
}

#define GAS __attribute__((address_space(1)))
#define LAS __attribute__((address_space(3)))
typedef unsigned short bf16;
typedef unsigned v4u __attribute__((ext_vector_type(4)));
typedef float f32x4 __attribute__((ext_vector_type(4)));
typedef short bf16x8 __attribute__((ext_vector_type(8)));
typedef GAS unsigned gu32;
typedef GAS unsigned long long gu64;
#define RLX_AGENT __ATOMIC_RELAXED, __HIP_MEMORY_SCOPE_AGENT
#define LDS_WAIT() asm volatile("s_waitcnt lgkmcnt(0)" ::: "memory")
#define VM_WAIT() asm volatile("s_waitcnt vmcnt(0)" ::: "memory")
__device__ __forceinline__ unsigned long long rt() { return __builtin_amdgcn_s_memrealtime(); }
__device__ __forceinline__ unsigned f2bf(float f) { unsigned u = __builtin_bit_cast(unsigned, f); return (u + 0x7fffu + ((u >> 16) & 1u)) >> 16; }
__device__ __forceinline__ unsigned pk2(float lo, float hi) { return f2bf(lo) | (f2bf(hi) << 16); }

#define XB_TMO      128
#define XB_XCNT(j)  (256  + 64 * (j))
#define XB_XSUB(j)  (1280 + 64 * (j))
#define XB_XGEN(j)  (2304 + 64 * (j))
#define XB_TOP      3328
#define XB_TOPGEN   3392
#define XCD_BAR_WORDS 3456
#define XB_SPIN_CAP (1u << 18)

__device__ __forceinline__ unsigned xb_ld(unsigned* p)              { return __hip_atomic_load(p, __ATOMIC_RELAXED, __HIP_MEMORY_SCOPE_AGENT); }
__device__ __forceinline__ unsigned xb_add(unsigned* p, unsigned v) { return __hip_atomic_fetch_add(p, v, __ATOMIC_RELAXED, __HIP_MEMORY_SCOPE_AGENT); }
__device__ __forceinline__ unsigned xb_xcc_id() { return (unsigned)__builtin_amdgcn_s_getreg((3 << 11) | 20) & 0xFu; }
#define XB_SPIN(cond, bar) do { unsigned _sp = 0; while (cond) { __builtin_amdgcn_s_sleep(1); \
    if ((++_sp & 255u) == 0u) { if (xb_ld(&(bar)[XB_TMO])) break; if (_sp > XB_SPIN_CAP) { atomicAdd(&(bar)[XB_TMO], 1u); break; } } } } while (0)

struct XcdBarrier {
    unsigned* bar; unsigned x;
    volatile LAS unsigned* st;
};

__device__ __forceinline__ XcdBarrier xcd_barrier_post(unsigned* bar, volatile LAS unsigned* st) {
    XcdBarrier b; b.bar = bar; b.x = xb_xcc_id(); b.st = st;
    if (threadIdx.x == 0) (void)xb_add(&bar[XB_XCNT(b.x)], 1u);
    return b;
}
__device__ __forceinline__ void xcd_barrier_complete(unsigned* bar, unsigned x, unsigned& nloc, unsigned& nx) {
    const unsigned G = gridDim.x * gridDim.y * gridDim.z;
    unsigned sum, cnt, mine, sp = 0u;
    for (;;) {
        sum = 0u; cnt = 0u; mine = 0u;
#pragma unroll
        for (unsigned j = 0; j < 16; ++j) { const unsigned c = xb_ld(&bar[XB_XCNT(j)]); sum += c; cnt += (c > 0u) ? 1u : 0u; mine = (j == x) ? c : mine; }
        if (sum == G) break;
        __builtin_amdgcn_s_sleep(1);
        if ((++sp & 255u) == 0u) { if (xb_ld(&bar[XB_TMO])) break; if (sp > XB_SPIN_CAP) { atomicAdd(&bar[XB_TMO], 1u); break; } }
    }
    nloc = mine > 0u ? mine : 1u; nx = cnt > 0u ? cnt : 1u;
}

__device__ __forceinline__ void xcd_barrier(const XcdBarrier& b) {
    asm volatile("s_waitcnt vmcnt(0)" ::: "memory");
    __syncthreads();
    if (threadIdx.x == 0) {
        unsigned* bar = b.bar;
        __builtin_amdgcn_s_waitcnt(0);
        unsigned nloc = b.st[0], nx = b.st[1];
        if (nloc == 0u) { xcd_barrier_complete(bar, b.x, nloc, nx); b.st[0] = nloc; b.st[1] = nx; }
        const unsigned old = xb_add(&bar[XB_XSUB(b.x)], 1u);
        const unsigned gen = old / nloc;
        if (old + 1u == (gen + 1u) * nloc) {
            __builtin_amdgcn_fence(__ATOMIC_RELEASE, "agent");
            asm volatile("s_waitcnt vmcnt(0)" ::: "memory");
            const unsigned og = xb_add(&bar[XB_TOP], 1u);
            const unsigned tg = og / nx;
            if (og + 1u == (tg + 1u) * nx) xb_add(&bar[XB_TOPGEN], 1u);
            else XB_SPIN(xb_ld(&bar[XB_TOPGEN]) == tg, bar);
            __builtin_amdgcn_fence(__ATOMIC_ACQUIRE, "agent");
            xb_add(&bar[XB_XGEN(b.x)], 1u);
            asm volatile("s_waitcnt vmcnt(0)" ::: "memory");
        } else {
            XB_SPIN(xb_ld(&bar[XB_XGEN(b.x)]) == gen, bar);
            __builtin_amdgcn_fence(__ATOMIC_ACQUIRE, "agent");
            asm volatile("s_waitcnt vmcnt(0)" ::: "memory");
        }
    }
    __syncthreads();
}
constexpr int NWAVES = 8;
#ifndef MK_ONE_LAUNCH
#define MK_ONE_LAUNCH 1
#endif
constexpr int N_PHASES = 6;
constexpr int BATCH = 4, SEQ = 4096, DMODEL = 2048, M = BATCH * SEQ, IN_W = 5952, N1 = 6144, QRANK = 512, KVRANK = 256, NQ = 1536, NKV = 2048;
constexpr size_t MiB = 1u << 20;
constexpr size_t WS_CTL = 0, CTL_ZERO_BYTES = 1 * MiB;
constexpr size_t WS_WIN = 2 * MiB, WS_WQB = 26 * MiB, WS_WKVB = 28 * MiB, WS_WOUT = 30 * MiB, WS_TRIG = 38 * MiB, WS_STATS = 42 * MiB, WS_YSTAT = 43 * MiB;
constexpr size_t WS_XN = 48 * MiB, WS_QL = 112 * MiB, WS_KVL = 128 * MiB, WS_KR = 136 * MiB, WS_GM = 138 * MiB, WS_GD = 170 * MiB, WS_DQ = 202 * MiB, WS_DK = 234 * MiB, WS_DV = 266 * MiB;
constexpr size_t WS_QM = 298 * MiB, WS_KVM = 346 * MiB, WS_MIX = 410 * MiB, WS_PARK = 474 * MiB, WS_END = 506 * MiB;
constexpr int CW_BAR = 4096;
constexpr int RING_OFF = 0, RING_BYTES = 131072, LDSCTL_OFF = RING_BYTES, MISC_OFF = LDSCTL_OFF + 320, LDS_BYTES = 147456;
static_assert(att::ATT_LDS_BYTES <= RING_BYTES, "attention scratch fits the ring region");

struct Args { const void* in[15]; float* out; unsigned char* ws; float freq[32]; int ph_lo, ph_hi; };

__device__ __forceinline__ float wave_sum(float v) {
#pragma unroll
    for (int o = 1; o < 64; o <<= 1) v += __shfl_xor(v, o);
    return v;
}
template <class MapN>
__device__ __forceinline__ void transpose_item(const float* W, int K, int N, bf16* WT, const float* kscale, MapN mapn, LAS float* scr, int item, int lane) {
    const int nblk = N / 32, kb = item / nblk, nb = item % nblk, k0 = 64 * kb, n0 = 32 * nb;
#pragma unroll 8
    for (int i = 0; i < 32; ++i) { const int kk = 2 * i + (lane >> 5); float v = W[(size_t)(k0 + kk) * N + n0 + (lane & 31)]; if (kscale) v *= kscale[k0 + kk]; scr[kk * 33 + (lane & 31)] = v; }
    LDS_WAIT(); asm volatile("" ::: "memory");
    const int c = lane & 7;
#pragma unroll
    for (int j = 0; j < 4; ++j) { const int n = (lane >> 3) + 8 * j; const LAS float* s = scr + (8 * c) * 33 + n;
        v4u o; o.x = pk2(s[0 * 33], s[1 * 33]); o.y = pk2(s[2 * 33], s[3 * 33]); o.z = pk2(s[4 * 33], s[5 * 33]); o.w = pk2(s[6 * 33], s[7 * 33]);
        *(GAS v4u*)(WT + (size_t)mapn(n0 + n) * K + k0 + 8 * c) = o; }
    LDS_WAIT(); asm volatile("" ::: "memory");
}
struct MapWin { __device__ __forceinline__ int operator()(int n) const { if (n < 768) return n; if (n < 832) { const int i = n - 768; return 768 + (i < 32 ? 2 * i : 2 * (i - 32) + 1); } return n + 192; } };
struct MapWqb { __device__ __forceinline__ int operator()(int n) const { const int h = n / 192, d = n - h * 192; if (d < 128) return n; const int i = d - 128; return h * 192 + 128 + (i < 32 ? 2 * i : 2 * (i - 32) + 1); } };
struct MapId  { __device__ __forceinline__ int operator()(int n) const { return n; } };

__global__ void __launch_bounds__(NWAVES * 64, 2) fwd_kernel(Args args) {
    extern __shared__ __attribute__((aligned(16))) unsigned char lds_raw[];
    LAS unsigned char* lds = (LAS unsigned char*)lds_raw;
    volatile LAS unsigned* MISC = (volatile LAS unsigned*)(lds + MISC_OFF);
    const int tid = threadIdx.x, lane = tid & 63, wave = __builtin_amdgcn_readfirstlane(tid >> 6);
    const int G = gridDim.x; const int bx = blockIdx.x; const int vcu = (G % 8 == 0) ? (bx % 8) * (G / 8) + bx / 8 : bx;
    unsigned char* ws = args.ws;
    gu32* ctl = (gu32*)(ws + WS_CTL);
    const float* x = (const float*)args.in[0]; const int* positions = (const int*)args.in[1]; const float* g_pre = (const float*)args.in[2]; const float* w_in = (const float*)args.in[3];
    const float* g_q_a = (const float*)args.in[4]; const float* w_q_b = (const float*)args.in[5]; const float* g_kv_a = (const float*)args.in[6]; const float* w_kv_b = (const float*)args.in[7];
    const float* lq1 = (const float*)args.in[8]; const float* lk1 = (const float*)args.in[9]; const float* lq2 = (const float*)args.in[10]; const float* lk2 = (const float*)args.in[11];
    const float* g_sub = (const float*)args.in[12]; const float* w_out = (const float*)args.in[13]; const float* g_post = (const float*)args.in[14];
    float* out = args.out;
    bf16* WinT = (bf16*)(ws + WS_WIN); bf16* WqbT = (bf16*)(ws + WS_WQB); bf16* WkvbT = (bf16*)(ws + WS_WKVB); bf16* WoutT = (bf16*)(ws + WS_WOUT);
    float* TRIG = (float*)(ws + WS_TRIG); float* STATS = (float*)(ws + WS_STATS); float* YSTAT = (float*)(ws + WS_YSTAT);
    bf16* XN = (bf16*)(ws + WS_XN); bf16* QL = (bf16*)(ws + WS_QL); bf16* KVL = (bf16*)(ws + WS_KVL); bf16* KR = (bf16*)(ws + WS_KR);
    bf16* GM = (bf16*)(ws + WS_GM); bf16* GD = (bf16*)(ws + WS_GD); bf16* DQ = (bf16*)(ws + WS_DQ); bf16* DK = (bf16*)(ws + WS_DK); bf16* DV = (bf16*)(ws + WS_DV);
    bf16* QM = (bf16*)(ws + WS_QM); bf16* KVM = (bf16*)(ws + WS_KVM); bf16* MIX = (bf16*)(ws + WS_MIX); float* PARK = (float*)(ws + WS_PARK);

    for (int u = tid; u < (LDS_BYTES - LDSCTL_OFF) / 4; u += NWAVES * 64) ((LAS unsigned*)(lds + LDSCTL_OFF))[u] = 0u;
    __syncthreads();
    XcdBarrier bar; bar.bar = (unsigned*)(ctl + CW_BAR); bar.x = 0; bar.st = nullptr;
#if MK_ONE_LAUNCH
    bar = xcd_barrier_post((unsigned*)(ctl + CW_BAR), MISC + 8);
#define GRID_BAR() xcd_barrier(bar)
#else
#define GRID_BAR() do {} while (0)
#endif
    const int lo = args.ph_lo, hi_ = args.ph_hi;
#ifndef PH_MASK
#define PH_MASK 63
#endif
#define IN(k) (((PH_MASK >> (k)) & 1) && lo <= (k) && (k) < hi_)
#define BOTH(k) (IN(k) && IN((k) + 1))
    const int gw = vcu * NWAVES + wave, NGW = G * NWAVES;

    if (IN(0)) {
        LAS float* scr = (LAS float*)(lds + RING_OFF + wave * 16384);
        constexpr int I_IN = (DMODEL / 64) * (IN_W / 32), I_QB = (QRANK / 64) * (NQ / 32), I_KVB = (KVRANK / 64) * (NKV / 32), I_OUT = (DMODEL / 64) * (DMODEL / 32);
        constexpr int NITEMS = I_IN + I_QB + I_KVB + I_OUT;
        for (int it = gw; it < NITEMS; it += NGW) {
            int r = it;
            if (r < I_IN) { transpose_item(w_in, DMODEL, IN_W, WinT, nullptr, MapWin(), scr, r, lane); continue; } r -= I_IN;
            if (r < I_QB) { transpose_item(w_q_b, QRANK, NQ, WqbT, g_q_a, MapWqb(), scr, r, lane); continue; } r -= I_QB;
            if (r < I_KVB) { transpose_item(w_kv_b, KVRANK, NKV, WkvbT, g_kv_a, MapId(), scr, r, lane); continue; } r -= I_KVB;
            transpose_item(w_out, DMODEL, DMODEL, WoutT, nullptr, MapId(), scr, r, lane);
        }
        for (int i = gw * 64 + lane; i < 192 * 256; i += NGW * 64) *(GAS v4u*)(WinT + (size_t)832 * DMODEL + (size_t)i * 8) = (v4u){0u, 0u, 0u, 0u};
        {
            f32x4 gp[8];
#pragma unroll
            for (int j = 0; j < 8; ++j) gp[j] = ((const GAS f32x4*)g_pre)[64 * j + lane];
            for (int m = gw; m < M; m += NGW) {
                const GAS f32x4* xr = (const GAS f32x4*)(x + (size_t)m * DMODEL) + lane; f32x4 v[8]; float s = 0.f;
#pragma unroll
                for (int j = 0; j < 8; ++j) { v[j] = xr[64 * j]; s += (v[j].x * v[j].x + v[j].y * v[j].y) + (v[j].z * v[j].z + v[j].w * v[j].w); }
                const float rstd = 1.0f / sqrtf(wave_sum(s) * (1.0f / DMODEL) + 1e-6f);
                GAS unsigned long long* o8 = (GAS unsigned long long*)(XN + (size_t)m * DMODEL) + lane;
#pragma unroll
                for (int j = 0; j < 8; ++j) { const f32x4 w = v[j] * rstd * gp[j]; o8[64 * j] = (unsigned long long)pk2(w.x, w.y) | ((unsigned long long)pk2(w.z, w.w) << 32); }
            }
        }
        for (int idx = gw * 64 + lane; idx < M * 32; idx += NGW * 64) {
            const int m = idx >> 5, i = idx & 31;
            const float ang = (float)positions[m] * args.freq[i];
            double f = (double)ang * 0.15915494309189535; f -= __builtin_rint(f);
            const double q = __builtin_rint(f * 4.0); const double t = (f - q * 0.25) * 6.283185307179586; const double t2 = t * t;
            const double sn = t * (1.0 + t2 * (-1.0 / 6 + t2 * (1.0 / 120 + t2 * (-1.0 / 5040 + t2 * (1.0 / 362880 + t2 * (-1.0 / 39916800 + t2 * (1.0 / 6227020800.0)))))));
            const double cs = 1.0 + t2 * (-0.5 + t2 * (1.0 / 24 + t2 * (-1.0 / 720 + t2 * (1.0 / 40320 + t2 * (-1.0 / 3628800 + t2 * (1.0 / 479001600.0 + t2 * (-1.0 / 87178291200.0)))))));
            const int qi = ((int)q) & 3; double s_, c_;
            if (qi == 0) { s_ = sn; c_ = cs; } else if (qi == 1) { s_ = cs; c_ = -sn; } else if (qi == 2) { s_ = -sn; c_ = -cs; } else { s_ = -cs; c_ = sn; }
            TRIG[(size_t)m * 64 + i] = (float)c_; TRIG[(size_t)m * 64 + 32 + i] = (float)s_;
        }
        if (BOTH(0)) GRID_BAR();
    }

    if (IN(1)) {
        pg8::Gemm g{XN, WinT, M, N1, DMODEL}; pg8::StaticOrder S; S.init(M, N1, G, bx);
        pg8::EpiProj E{QL, KVL, KR, GM, GD, DQ, DK, DV, STATS, TRIG};
        pg8::gemm_phase<pg8::EpiProj, pg8::StaticOrder, true, true>(lds + RING_OFF, g, S, E);
        if (BOTH(1)) GRID_BAR();
    }

    if (IN(2)) {
        { pg8::Gemm g{QL, WqbT, M, NQ, QRANK}; pg8::StaticOrder S; S.init(M, NQ, G, bx);
          pg8::EpiQ E{QM, STATS, TRIG};
          pg8::gemm_phase<pg8::EpiQ, pg8::StaticOrder, true, true>(lds + RING_OFF, g, S, E); }
        { pg8::Gemm g{KVL, WkvbT, M, NKV, KVRANK}; pg8::StaticOrder S; S.init(M, NKV, G, bx);
          pg8::EpiKV E{KVM, STATS};
          pg8::gemm_phase<pg8::EpiKV, pg8::StaticOrder, true, true>(lds + RING_OFF, g, S, E); }
        if (BOTH(2)) GRID_BAR();
    }

    if (IN(3)) {
        float lam;
        { const float a = wave_sum(lq1[lane] * lk1[lane]), b2 = wave_sum(lq2[lane] * lk2[lane]); lam = expf(a) - expf(b2) + 0.2f; }
        const att::Ptrs P{QM, KVM, KR, DQ, DK, DV, GM, GD, MIX, positions, g_sub};
        LAS char* al = (LAS char*)(lds + RING_OFF);
        for (int it = vcu; it < 256; it += G) {
            const int bh = it >> 3, s = it & 7, b = bh >> 3, h = bh & 7;
            #ifndef NO_MLA
            att::mla_unit(P, b, h, s, al); att::mla_unit(P, b, h, 15 - s, al);
#endif
#ifndef NO_DIFF
            att::diff_unit(P, b, h, s, al, lam, PARK + (size_t)(bx * NWAVES + wave) * 4096); att::diff_unit(P, b, h, 15 - s, al, lam, PARK + (size_t)(bx * NWAVES + wave) * 4096);
#endif
        }
        if (BOTH(3)) GRID_BAR();
    }

    if (IN(4)) {
        pg8::Gemm g{MIX, WoutT, M, DMODEL, DMODEL}; pg8::StaticOrder S; S.init(M, DMODEL, G, bx);
        pg8::EpiY E{out, YSTAT};
        pg8::gemm_phase<pg8::EpiY, pg8::StaticOrder, true, true>(lds + RING_OFF, g, S, E);
        if (BOTH(4)) GRID_BAR();
    }

    if (IN(5)) {
        f32x4 gp[8];
#pragma unroll
        for (int j = 0; j < 8; ++j) gp[j] = ((const GAS f32x4*)g_post)[64 * j + lane];
        for (int m = gw; m < M; m += NGW) {
            const GAS f32x4* xr = (const GAS f32x4*)(x + (size_t)m * DMODEL) + lane; GAS f32x4* yr = (GAS f32x4*)(out + (size_t)m * DMODEL) + lane;
            const float ss = wave_sum(lane < 32 ? YSTAT[(size_t)m * 32 + lane] : 0.f);
            const float rstd = 1.0f / sqrtf(ss * (1.0f / DMODEL) + 1e-6f);
#pragma unroll
            for (int j = 0; j < 8; ++j) { const f32x4 y = yr[64 * j], xv = xr[64 * j]; yr[64 * j] = xv + y * rstd * gp[j]; }
        }
    }
#undef IN
#undef BOTH
}

extern "C" void kernel_launch(void* const* d_in, const int* in_sizes, int n_in, void* d_out, int out_size, void* d_ws, size_t ws_size, hipStream_t stream) {
    static int grid = 0;
    if (grid == 0) {
        if (n_in != 15 || in_sizes[0] != M * DMODEL || out_size != M * DMODEL || ws_size < WS_END) { fprintf(stderr, "kernel_launch: unexpected shapes (n_in %d, in0 %d, out %d, ws %zu)\n", n_in, n_in > 0 ? in_sizes[0] : -1, out_size, ws_size); grid = -1; return; }
        int dev = 0, cus = 0, per_cu = 0;
        if (hipGetDevice(&dev) != hipSuccess || hipDeviceGetAttribute(&cus, hipDeviceAttributeMultiprocessorCount, dev) != hipSuccess) { grid = -1; return; }
        if (hipFuncSetAttribute((const void*)fwd_kernel, hipFuncAttributeMaxDynamicSharedMemorySize, LDS_BYTES) != hipSuccess) { fprintf(stderr, "kernel_launch: hipFuncSetAttribute failed\n"); grid = -1; return; }
        if (hipOccupancyMaxActiveBlocksPerMultiprocessor(&per_cu, (const void*)fwd_kernel, NWAVES * 64, LDS_BYTES) != hipSuccess || per_cu < 1) fprintf(stderr, "kernel_launch: occupancy query reports %d blocks/CU\n", per_cu);
        (void)hipGetLastError();
        grid = cus > 256 ? 256 : cus;
    }
    if (grid < 0) return;
    if (hipMemsetAsync((char*)d_ws + WS_CTL, 0, CTL_ZERO_BYTES, stream) != hipSuccess) { fprintf(stderr, "kernel_launch: memset failed\n"); return; }
    Args a{};
    for (int i = 0; i < 15; ++i) a.in[i] = d_in[i];
    a.out = (float*)d_out; a.ws = (unsigned char*)d_ws;
    for (int i = 0; i < 32; ++i) a.freq[i] = 1.0f / powf(10000.0f, (float)(2 * i) / 64.0f);
#if MK_ONE_LAUNCH
    a.ph_lo = 0; a.ph_hi = N_PHASES;
    hipLaunchKernelGGL(fwd_kernel, dim3(grid), dim3(NWAVES * 64), LDS_BYTES, stream, a);
#else
    for (int p = 0; p < N_PHASES; ++p) { a.ph_lo = p; a.ph_hi = p + 1; hipLaunchKernelGGL(fwd_kernel, dim3(grid), dim3(NWAVES * 64), LDS_BYTES, stream, a); }
#endif
    const hipError_t le = hipPeekAtLastError();
    if (le != hipSuccess) fprintf(stderr, "kernel_launch: launch failed: %s\n", hipGetErrorName(le));
}
```

```cpp
#include <hip/hip_runtime.h>
#include <hip/hip_bf16.h>
#include <cstdio>
#include <cstdint>
#include <cmath>
namespace pg8 {
#define PG8_LAS __attribute__((address_space(3)))
typedef unsigned short bf16_t;
typedef short bf16x8 __attribute__((ext_vector_type(8)));
typedef float f32x4 __attribute__((ext_vector_type(4)));
typedef unsigned u32x4 __attribute__((ext_vector_type(4)));
constexpr int BM = 256, BK = 64, HALF = 128, HTB = HALF * BK * 2  , STAGE_BYTES = 8 * HTB, NXCD = 8, WGM = 8;

__host__ __device__ __forceinline__ int lds_byte(int r, int c) { const int st = (r >> 4) * 2 + (c >> 5), rr = r & 15, cc = c & 31, ob = rr * 64 + cc * 2; return st * 1024 + (ob ^ (((ob >> 9) & 1) << 5)); }
__host__ __device__ __forceinline__ void stage_rc(int b, int& R, int& C) { const int st = b / 1024, sb = b % 1024, swz = sb ^ (((sb >> 9) & 1) << 5); R = (st >> 1) * 16 + swz / 64; C = (st & 1) * 32 + (swz % 64) / 2; }
__host__ __device__ __forceinline__ int perm32(int rho) { const int n = rho >> 4, i = rho & 15; return 8 * (i >> 2) + 4 * n + (i & 3); }

struct Unit { int pm, pn; };
struct Gemm { const bf16_t* A; const bf16_t* Bt; int M, N, K; };

struct StaticOrder {
    int nM, nN, nwg, G, c;
    __host__ __device__ void init(int M, int N, int G_, int c_) { nM = M / BM; nN = N / BM; nwg = nM * nN; G = G_; c = c_; }
    __host__ __device__ bool next(int i, Unit& u) const {
        const long L = (long)i * G + c; if (L >= nwg) return false;
        int wgid = (int)L; { const int q = nwg / NXCD, r = nwg % NXCD, xcd = wgid % NXCD, off = wgid / NXCD; wgid = (xcd < r ? xcd * (q + 1) : r * (q + 1) + (xcd - r) * q) + off; }
        const int nig = WGM * nN, gid = wgid / nig, fm = gid * WGM, gsz = (nM - fm) < WGM ? (nM - fm) : WGM;
        u.pm = fm + ((wgid % nig) % gsz); u.pn = (wgid % nig) / gsz; return true;
    }
    __device__ __forceinline__ void a_ready(const Unit&) const {}
    __device__ __forceinline__ void done(const Unit&) const {}
};

__device__ __forceinline__ unsigned cvt_pk_bf16(float lo, float hi) { unsigned r; asm volatile("v_cvt_pk_bf16_f32 %0, %1, %2" : "=v"(r) : "v"(lo), "v"(hi)); return r; }
typedef float f32x2 __attribute__((ext_vector_type(2)));
constexpr float EPSN = 1e-6f;
constexpr float LOG2E = 1.4426950408889634f;
constexpr float QSCALE_MLA = 0.07216878364870322f * LOG2E;
constexpr float QSCALE_DIFF = 0.125f * LOG2E;
typedef unsigned u32x2 __attribute__((ext_vector_type(2)));
__device__ __forceinline__ u32x4 pack8(const f32x4 v0, const f32x4 v1) { u32x4 w; w.x = cvt_pk_bf16(v0[0], v0[1]); w.y = cvt_pk_bf16(v0[2], v0[3]); w.z = cvt_pk_bf16(v1[0], v1[1]); w.w = cvt_pk_bf16(v1[2], v1[3]); return w; }
__device__ __forceinline__ float silu_f(float x) { return x * __builtin_amdgcn_rcpf(1.0f + __builtin_amdgcn_exp2f(-x * LOG2E)); }
__device__ __forceinline__ f32x4 silu4(f32x4 v) { f32x4 o; o[0] = silu_f(v[0]); o[1] = silu_f(v[1]); o[2] = silu_f(v[2]); o[3] = silu_f(v[3]); return o; }
__device__ __forceinline__ void rope_store(const f32x4 v0, const f32x4 v1, const float* trig, int i0, bf16_t* dst_lo, bf16_t* dst_hi) {
    const f32x4 cs = *(const f32x4*)(trig + i0), sn = *(const f32x4*)(trig + 32 + i0);
    const f32x4 t1 = {v0[0], v0[2], v1[0], v1[2]}, t2 = {v0[1], v0[3], v1[1], v1[3]};
    const f32x4 o1 = t1 * cs - t2 * sn, o2 = t2 * cs + t1 * sn;
    u32x2 a, b; a.x = cvt_pk_bf16(o1[0], o1[1]); a.y = cvt_pk_bf16(o1[2], o1[3]); b.x = cvt_pk_bf16(o2[0], o2[1]); b.y = cvt_pk_bf16(o2[2], o2[3]);
    *(u32x2*)dst_lo = a; *(u32x2*)dst_hi = b;
}
struct EpiProj {
    static constexpr bool PERM = true, AFTER_DRAIN = false;
    bf16_t *QL, *KVL, *KR, *GM, *GD, *DQ, *DK, *DV; float* STATS; const float* TRIG;
    __device__ __forceinline__ void operator()(const f32x4 (&acc)[2][2][4][2], const Unit& u, int wr, int wc, int fr, int fq) const {
        const int pn = u.pn; const int row0 = u.pm * BM + wr * 64 + fr; const int cw = wc * 32 + 8 * fq;
        if (pn < 3) {
            bf16_t* base; int ld, ct, slot;
            if (pn < 2) { base = QL; ld = 512; ct = pn * 256; slot = pn * 4 + wc; } else { base = KVL; ld = 256; ct = 0; slot = 8 + wc; }
#pragma unroll
            for (int ai = 0; ai < 2; ++ai)
#pragma unroll
                for (int m = 0; m < 4; ++m) { const int row = row0 + ai * HALF + m * 16; float s = 0.f;
#pragma unroll
                    for (int bj = 0; bj < 2; ++bj) { const f32x4 v0 = acc[ai][bj][m][0], v1 = acc[ai][bj][m][1];
                        s += (v0[0] * v0[0] + v0[1] * v0[1]) + (v0[2] * v0[2] + v0[3] * v0[3]) + (v1[0] * v1[0] + v1[1] * v1[1]) + (v1[2] * v1[2] + v1[3] * v1[3]);
                        *(u32x4*)(base + (size_t)row * ld + ct + bj * HALF + cw) = pack8(v0, v1); }
                    s += __shfl_xor(s, 16); s += __shfl_xor(s, 32);
                    if (fq == 0) STATS[(size_t)row * 12 + slot] = s; }
        } else if (pn == 3) {
            if (wc < 2) { const int i0 = 16 * wc + 4 * fq;
#pragma unroll
                for (int ai = 0; ai < 2; ++ai)
#pragma unroll
                    for (int m = 0; m < 4; ++m) { const int row = row0 + ai * HALF + m * 16;
                        rope_store(acc[ai][0][m][0], acc[ai][0][m][1], TRIG + (size_t)row * 64, i0, KR + (size_t)row * 64 + i0, KR + (size_t)row * 64 + 32 + i0); } }
        } else {
            const int g = (pn - 4) >> 2; bf16_t* base = g == 0 ? GM : g == 1 ? DQ : g == 2 ? DK : g == 3 ? DV : GD; const int ct = ((pn - 4) & 3) * 256;
            const bool act = (g == 0 || g == 4); const float sc = (g == 1) ? QSCALE_DIFF : 1.0f;
#pragma unroll
            for (int ai = 0; ai < 2; ++ai)
#pragma unroll
                for (int m = 0; m < 4; ++m) { const int row = row0 + ai * HALF + m * 16;
#pragma unroll
                    for (int bj = 0; bj < 2; ++bj) { f32x4 v0 = acc[ai][bj][m][0], v1 = acc[ai][bj][m][1];
                        if (act) { v0 = silu4(v0); v1 = silu4(v1); } else { v0 = v0 * sc; v1 = v1 * sc; }
                        *(u32x4*)(base + (size_t)row * 1024 + ct + bj * HALF + cw) = pack8(v0, v1); } }
        }
    }
};
struct EpiQ {
    static constexpr bool PERM = true, AFTER_DRAIN = false;
    bf16_t* QM; const float* STATS; const float* TRIG;
    __device__ __forceinline__ void operator()(const f32x4 (&acc)[2][2][4][2], const Unit& u, int wr, int wc, int fr, int fq) const {
        const int row0 = u.pm * BM + wr * 64 + fr; const int cw = u.pn * BM + wc * 32 + 8 * fq;
#pragma unroll
        for (int ai = 0; ai < 2; ++ai)
#pragma unroll
            for (int m = 0; m < 4; ++m) { const int row = row0 + ai * HALF + m * 16;
                const f32x4 sa = *(const f32x4*)(STATS + (size_t)row * 12), sb = *(const f32x4*)(STATS + (size_t)row * 12 + 4);
                const float ss = ((sa[0] + sa[1]) + (sa[2] + sa[3])) + ((sb[0] + sb[1]) + (sb[2] + sb[3]));
                const float rs = QSCALE_MLA / sqrtf(ss * (1.0f / 512.0f) + EPSN);
#pragma unroll
                for (int bj = 0; bj < 2; ++bj) { const int c0 = cw + bj * HALF; const int h = c0 / 192, d = c0 - h * 192;
                    const f32x4 v0 = acc[ai][bj][m][0] * rs, v1 = acc[ai][bj][m][1] * rs;
                    if (d < 128) *(u32x4*)(QM + (size_t)row * 1536 + c0) = pack8(v0, v1);
                    else { const int i0 = (d - 128) >> 1; bf16_t* q = QM + (size_t)row * 1536 + h * 192 + 128 + i0; rope_store(v0, v1, TRIG + (size_t)row * 64, i0, q, q + 32); } } }
    }
};
struct EpiKV {
    static constexpr bool PERM = true, AFTER_DRAIN = false;
    bf16_t* KVM; const float* STATS;
    __device__ __forceinline__ void operator()(const f32x4 (&acc)[2][2][4][2], const Unit& u, int wr, int wc, int fr, int fq) const {
        const int row0 = u.pm * BM + wr * 64 + fr; const int cw = u.pn * BM + wc * 32 + 8 * fq;
#pragma unroll
        for (int ai = 0; ai < 2; ++ai)
#pragma unroll
            for (int m = 0; m < 4; ++m) { const int row = row0 + ai * HALF + m * 16;
                const f32x4 sa = *(const f32x4*)(STATS + (size_t)row * 12 + 8);
                const float ss = (sa[0] + sa[1]) + (sa[2] + sa[3]);
                const float rs = 1.0f / sqrtf(ss * (1.0f / 256.0f) + EPSN);
#pragma unroll
                for (int bj = 0; bj < 2; ++bj) *(u32x4*)(KVM + (size_t)row * 2048 + cw + bj * HALF) = pack8(acc[ai][bj][m][0] * rs, acc[ai][bj][m][1] * rs); }
    }
};
struct EpiY {
    static constexpr bool PERM = false, AFTER_DRAIN = false;
    float* Y; float* YSTAT;
    __device__ __forceinline__ void operator()(const f32x4 (&acc)[2][2][4][2], const Unit& u, int wr, int wc, int fr, int fq) const {
        const int row0 = u.pm * BM + wr * 64 + fr; const int col0 = u.pn * BM + wc * 32 + 4 * fq;
#pragma unroll
        for (int ai = 0; ai < 2; ++ai)
#pragma unroll
            for (int m = 0; m < 4; ++m) { const int row = row0 + ai * HALF + m * 16; float s = 0.f;
#pragma unroll
                for (int bj = 0; bj < 2; ++bj)
#pragma unroll
                    for (int n = 0; n < 2; ++n) { const f32x4 v = acc[ai][bj][m][n]; s += (v[0] * v[0] + v[1] * v[1]) + (v[2] * v[2] + v[3] * v[3]);
                        *(f32x4*)(Y + (size_t)row * 2048 + col0 + bj * HALF + n * 16) = v; }
                s += __shfl_xor(s, 16); s += __shfl_xor(s, 32);
                if (fq == 0) YSTAT[(size_t)row * 32 + u.pn * 4 + wc] = s; }
    }
};

template <class Epi, class Sched, bool ALIGN_EPI = false, bool SP2 = false>
__device__ __forceinline__ void gemm_phase(PG8_LAS unsigned char* lds, const Gemm g, const Sched& S, const Epi& E) {
    const int tid = threadIdx.x, wid = __builtin_amdgcn_readfirstlane(tid >> 6), lane = tid & 63, wr = wid >> 2, wc = wid & 3, fr = lane & 15, fq = lane >> 4;
    const int K = g.K, nt = K / BK;
    unsigned voffA[2], voffB[2];
#pragma unroll
    for (int i = 0; i < 2; ++i) { int R, C; stage_rc(tid * 16 + i * 8192, R, C); const int Rb = Epi::PERM ? ((R & ~31) + perm32(R & 31)) : R;
        voffA[i] = (unsigned)(R * K + C) * 2u; voffB[i] = (unsigned)(Rb * K + C) * 2u; }
    const size_t kstep = (size_t)(BK * 2);
    const size_t hstep = (size_t)HALF * K * 2;
    const size_t tstep = 2 * hstep;
    const unsigned ldsw = (unsigned)wid * 1024u;
    const int aoff = lds_byte(wr * 64 + fr, fq * 8), boff = lds_byte(wc * 32 + fr, fq * 8);
#define PG8_SA(b, h) (((b) * 2 + (h)) * HTB)
#define PG8_SB(b, h) ((4 + (b) * 2 + (h)) * HTB)
#define PG8_STAGE(bufoff, gbase, voff) do { _Pragma("unroll") for (int _i = 0; _i < 2; ++_i) \
        __builtin_amdgcn_global_load_lds((const unsigned*)((const char*)(gbase) + (voff)[_i]), (PG8_LAS unsigned*)(lds + (bufoff) + ldsw + _i * 8192), 16, 0, 0); } while (0)
#define PG8_LDA(dst, b, h) do { _Pragma("unroll") for (int m = 0; m < 4; ++m) _Pragma("unroll") for (int k = 0; k < 2; ++k) dst[m][k] = *(const PG8_LAS bf16x8*)(lds + PG8_SA(b, h) + aoff + m * 2048 + k * 1024); } while (0)
#define PG8_LDB(dst, b, h) do { _Pragma("unroll") for (int n = 0; n < 2; ++n) _Pragma("unroll") for (int k = 0; k < 2; ++k) dst[n][k] = *(const PG8_LAS bf16x8*)(lds + PG8_SB(b, h) + boff + n * 2048 + k * 1024); } while (0)
#define PG8_MMA(ai, bj, At, Bt) do { __builtin_amdgcn_s_setprio(1); _Pragma("unroll") for (int m = 0; m < 4; ++m) _Pragma("unroll") for (int n = 0; n < 2; ++n) _Pragma("unroll") for (int k = 0; k < 2; ++k) \
        acc[ai][bj][m][n] = __builtin_amdgcn_mfma_f32_16x16x32_bf16(Bt[n][k], At[m][k], acc[ai][bj][m][n], 0, 0, 0); __builtin_amdgcn_s_setprio(0); } while (0)
#define PG8_WAIT_V(n) asm volatile("s_waitcnt vmcnt(" #n ")" ::: "memory")
#define PG8_WAIT_L(n) asm volatile("s_waitcnt lgkmcnt(" #n ")" ::: "memory")
#define PG8_BAR __builtin_amdgcn_s_barrier()
#define PG8_SCHED __builtin_amdgcn_sched_barrier(0)
    Unit cur, nxt; int ui = 0;
    if (!S.next(0, cur)) return;
    f32x4 acc[2][2][4][2];
#pragma unroll
    for (int a = 0; a < 2; ++a)
#pragma unroll
        for (int b = 0; b < 2; ++b)
#pragma unroll
            for (int m = 0; m < 4; ++m)
#pragma unroll
                for (int n = 0; n < 2; ++n) acc[a][b][m][n] = (f32x4){0.f, 0.f, 0.f, 0.f};
    bf16x8 At[4][2], B0[2][2], B1[2][2];
    const char* cA = (const char*)g.A + (size_t)cur.pm * tstep; const char* cB = (const char*)g.Bt + (size_t)cur.pn * tstep;
    S.a_ready(cur);
    if constexpr (SP2) {
        PG8_STAGE(PG8_SB(0, 0), cB, voffB); PG8_STAGE(PG8_SB(0, 1), cB + hstep, voffB); PG8_STAGE(PG8_SA(0, 0), cA, voffA); PG8_STAGE(PG8_SA(0, 1), cA + hstep, voffA);
        if (wr == 1) PG8_BAR;
        PG8_WAIT_V(2); PG8_BAR;
        PG8_STAGE(PG8_SB(1, 0), cB + kstep, voffB); PG8_STAGE(PG8_SA(1, 0), cA + kstep, voffA); PG8_STAGE(PG8_SB(1, 1), cB + hstep + kstep, voffB);
        PG8_WAIT_V(6); PG8_BAR;
    } else {
        PG8_STAGE(PG8_SB(0, 0), cB, voffB); PG8_STAGE(PG8_SA(0, 0), cA, voffA); PG8_STAGE(PG8_SB(0, 1), cB + hstep, voffB); PG8_STAGE(PG8_SA(0, 1), cA + hstep, voffA);
        if (wr == 1) PG8_BAR;
        PG8_WAIT_V(4); PG8_BAR;
        PG8_STAGE(PG8_SB(1, 0), cB + kstep, voffB); PG8_STAGE(PG8_SA(1, 0), cA + kstep, voffA); PG8_STAGE(PG8_SB(1, 1), cB + hstep + kstep, voffB);
        PG8_WAIT_V(6); PG8_BAR;
    }
    for (;;) {
        const bool has_next = S.next(ui + 1, nxt);
        const char* nA = has_next ? (const char*)g.A + (size_t)nxt.pm * tstep : cA; const char* nB = has_next ? (const char*)g.Bt + (size_t)nxt.pn * tstep : cB;
        for (int t = 0; t < nt; t += 2) {
            const bool last = (t == nt - 2);
            const char* a1 = cA + (size_t)(t + 1) * kstep;
            const char* a2 = last ? nA : cA + (size_t)(t + 2) * kstep; const char* b2 = last ? nB : cB + (size_t)(t + 2) * kstep;
            const char* a3 = a2 + kstep; const char* b3 = b2 + kstep;
            if (last && has_next) S.a_ready(nxt);
            if constexpr (SP2) {
            PG8_LDB(B0, 0, 0); PG8_LDB(B1, 0, 1); PG8_SCHED; PG8_LDA(At, 0, 0); PG8_STAGE(PG8_SA(1, 1), a1 + hstep, voffA);
            PG8_WAIT_V(8); PG8_WAIT_L(0); PG8_BAR; PG8_MMA(0, 0, At, B0); PG8_MMA(0, 1, At, B1); PG8_BAR; PG8_SCHED;
            PG8_LDA(At, 0, 1); PG8_STAGE(PG8_SB(0, 0), b2, voffB); PG8_STAGE(PG8_SB(0, 1), b2 + hstep, voffB); PG8_STAGE(PG8_SA(0, 0), a2, voffA);
            PG8_WAIT_V(8); PG8_WAIT_L(0); PG8_BAR; PG8_MMA(1, 0, At, B0); PG8_MMA(1, 1, At, B1); PG8_BAR; PG8_SCHED;
            PG8_LDB(B0, 1, 0); PG8_LDB(B1, 1, 1); PG8_SCHED; PG8_LDA(At, 1, 0); PG8_STAGE(PG8_SA(0, 1), a2 + hstep, voffA);
            PG8_WAIT_V(8); PG8_WAIT_L(0); PG8_BAR; PG8_MMA(0, 0, At, B0); PG8_MMA(0, 1, At, B1); PG8_BAR; PG8_SCHED;
            PG8_LDA(At, 1, 1); PG8_STAGE(PG8_SB(1, 0), b3, voffB); PG8_STAGE(PG8_SB(1, 1), b3 + hstep, voffB); PG8_STAGE(PG8_SA(1, 0), a3, voffA);
            PG8_WAIT_V(8); PG8_WAIT_L(0); PG8_BAR; PG8_MMA(1, 0, At, B0); PG8_MMA(1, 1, At, B1); PG8_BAR; PG8_SCHED;
            } else {
            PG8_LDB(B0, 0, 0); PG8_SCHED; PG8_LDA(At, 0, 0); PG8_STAGE(PG8_SA(1, 1), a1 + hstep, voffA);
            PG8_WAIT_L(8); PG8_BAR; PG8_WAIT_L(0); PG8_MMA(0, 0, At, B0); PG8_BAR; PG8_SCHED;
            PG8_LDB(B1, 0, 1); PG8_STAGE(PG8_SB(0, 0), b2, voffB);
            PG8_BAR; PG8_WAIT_L(0); PG8_MMA(0, 1, At, B1); PG8_BAR;
            PG8_LDA(At, 0, 1); PG8_STAGE(PG8_SA(0, 0), a2, voffA);
            PG8_BAR; PG8_WAIT_L(0); PG8_MMA(1, 0, At, B0); PG8_BAR; PG8_SCHED;
            PG8_STAGE(PG8_SB(0, 1), b2 + hstep, voffB);
            PG8_WAIT_V(6); PG8_BAR; PG8_MMA(1, 1, At, B1); PG8_BAR;
            PG8_LDB(B0, 1, 0); PG8_SCHED; PG8_LDA(At, 1, 0); PG8_STAGE(PG8_SA(0, 1), a2 + hstep, voffA);
            PG8_WAIT_L(8); PG8_BAR; PG8_WAIT_L(0); PG8_MMA(0, 0, At, B0); PG8_BAR; PG8_SCHED;
            PG8_LDB(B1, 1, 1); PG8_STAGE(PG8_SB(1, 0), b3, voffB);
            PG8_BAR; PG8_WAIT_L(0); PG8_MMA(0, 1, At, B1); PG8_BAR;
            PG8_LDA(At, 1, 1); PG8_STAGE(PG8_SA(1, 0), a3, voffA);
            PG8_BAR; PG8_WAIT_L(0); PG8_MMA(1, 0, At, B0); PG8_BAR; PG8_SCHED;
            PG8_STAGE(PG8_SB(1, 1), b3 + hstep, voffB);
            PG8_WAIT_V(6); PG8_BAR; PG8_MMA(1, 1, At, B1); PG8_BAR;
            }
        }
        if constexpr (ALIGN_EPI) { if (wr == 0) PG8_BAR; }
        if constexpr (!Epi::AFTER_DRAIN) { E(acc, cur, wr, wc, fr, fq); S.done(cur); }
        if (!has_next) break;
#pragma unroll
        for (int a = 0; a < 2; ++a)
#pragma unroll
            for (int b = 0; b < 2; ++b)
#pragma unroll
                for (int m = 0; m < 4; ++m)
#pragma unroll
                    for (int n = 0; n < 2; ++n) acc[a][b][m][n] = (f32x4){0.f, 0.f, 0.f, 0.f};
        cur = nxt; cA = nA; cB = nB; ++ui;
        if constexpr (ALIGN_EPI) { if (wr == 1) PG8_BAR; }
    }
    PG8_WAIT_V(0);
    if constexpr (!ALIGN_EPI) { if (wr == 0) PG8_BAR; }
    PG8_BAR;
    if constexpr (Epi::AFTER_DRAIN) { E.fused(acc, cur, wr, wc, fr, fq, lds, wid, lane); S.done(cur); }
#undef PG8_SA
#undef PG8_SB
#undef PG8_STAGE
#undef PG8_LDA
#undef PG8_LDB
#undef PG8_MMA
#undef PG8_WAIT_V
#undef PG8_WAIT_L
#undef PG8_BAR
#undef PG8_SCHED
}
}
namespace att {
#define ALAS __attribute__((address_space(3)))
using bf16 = unsigned short;
using bf16x8 = __attribute__((ext_vector_type(8))) short;
using s16x4  = __attribute__((ext_vector_type(4))) short;
using f32x16 = __attribute__((ext_vector_type(16))) float;
using f32x4  = __attribute__((ext_vector_type(4))) float;
using u32x4  = __attribute__((ext_vector_type(4))) unsigned;
constexpr int SEQ = 4096, NW = 8, QBLK = 32, KVBLK = 64;
constexpr float THR = 8.f;
constexpr float LOG2E = 1.4426950408889634f;
constexpr int KBUF_BYTES = 24576, K_OFF = 0, KR_OFF = 16384, VBUF_BYTES = 16384, V_BASE = 2 * KBUF_BYTES;
constexpr int WS_OFF = V_BASE + 3 * VBUF_BYTES, POSK_OFF = WS_OFF + NW * 256, ATT_LDS_BYTES = POSK_OFF + SEQ * 4;
#define SBAR() __builtin_amdgcn_sched_barrier(0)
__device__ __forceinline__ int crow(int r, int hi) { return (r & 3) + 8 * (r >> 2) + 4 * hi; }
__device__ __forceinline__ unsigned cvtpk(float lo, float hi) { unsigned r; asm volatile("v_cvt_pk_bf16_f32 %0, %1, %2" : "=v"(r) : "v"(lo), "v"(hi)); return r; }
__device__ __forceinline__ int opq(int x) { asm volatile("" : "+v"(x)); return x; }
__device__ __forceinline__ float bf2f(bf16 v) { return __uint_as_float((unsigned)v << 16); }
__device__ __forceinline__ bf16 f2bf(float f) { unsigned u = __float_as_uint(f); return (bf16)((u + 0x7fffu + ((u >> 16) & 1u)) >> 16); }
__device__ __forceinline__ void glds16(const void* g, ALAS char* l) { __builtin_amdgcn_global_load_lds((const unsigned*)g, (ALAS unsigned*)l, 16, 0, 0); }

__device__ __forceinline__ unsigned off_k256(int i, int ld, int wid, int lane) { const int piece = i * 8 + wid, row = piece * 4 + (lane >> 4), c = (lane & 15) ^ (row & 7); return (unsigned)(row * ld + c * 8) * 2u; }
__device__ __forceinline__ unsigned off_k128(int ld, int wid, int lane) { const int row = wid * 8 + (lane >> 3), c = (lane & 7) ^ ((row >> 1) & 7); return (unsigned)(row * ld + c * 8) * 2u; }
__device__ __forceinline__ unsigned off_v(int i, int ld, int wid, int lane) { const int piece = i * 8 + wid, p = piece * 64 + lane, sub = p >> 5, kk = (sub >> 2) * 8 + ((p & 31) >> 2);
  const int k = (kk & ~0xC) | ((kk & 4) << 1) | ((kk & 8) >> 1), col = (sub & 3) * 32 + (p & 3) * 8; return (unsigned)(k * ld + col) * 2u; }
__device__ __forceinline__ int v_rd_base(int lane) { return ((lane & 3) << 3) | (((lane >> 2) & 3) << 6) | (((lane >> 4) & 1) << 5) | (((lane >> 5) & 1) << 8); }
constexpr int v_rd_off(int d0, int ks, int half) { return d0 * 512 + ks * 4096 + half * 2048; }
template <int OFF> __device__ __forceinline__ s16x4 tr_read(int vb) { s16x4 r; asm volatile("ds_read_b64_tr_b16 %0, %1 offset:%2" : "=&v"(r) : "v"(vb), "i"(OFF) : "memory"); return r; }
template <int D0> __device__ __forceinline__ void pv_one(f32x16& od, int vb, bf16x8 pa0, bf16x8 pa1, bf16x8 pa2, bf16x8 pa3) {
  const s16x4 l0 = tr_read<v_rd_off(D0, 0, 0)>(vb), h0 = tr_read<v_rd_off(D0, 0, 1)>(vb), l1 = tr_read<v_rd_off(D0, 1, 0)>(vb), h1 = tr_read<v_rd_off(D0, 1, 1)>(vb);
  const s16x4 l2 = tr_read<v_rd_off(D0, 2, 0)>(vb), h2 = tr_read<v_rd_off(D0, 2, 1)>(vb), l3 = tr_read<v_rd_off(D0, 3, 0)>(vb), h3 = tr_read<v_rd_off(D0, 3, 1)>(vb);
  asm volatile("s_waitcnt lgkmcnt(0)" ::: "memory"); SBAR();
#define PK(L, H) (bf16x8){L[0], L[1], L[2], L[3], H[0], H[1], H[2], H[3]}
  od = __builtin_amdgcn_mfma_f32_32x32x16_bf16(pa0, PK(l0, h0), od, 0, 0, 0);
  od = __builtin_amdgcn_mfma_f32_32x32x16_bf16(pa1, PK(l1, h1), od, 0, 0, 0);
  od = __builtin_amdgcn_mfma_f32_32x32x16_bf16(pa2, PK(l2, h2), od, 0, 0, 0);
  od = __builtin_amdgcn_mfma_f32_32x32x16_bf16(pa3, PK(l3, h3), od, 0, 0, 0);
#undef PK
}
__device__ __forceinline__ void pv_d0(f32x16* o, int vb, bf16x8 pa0, bf16x8 pa1, bf16x8 pa2, bf16x8 pa3) {
  pv_one<0>(o[0], vb, pa0, pa1, pa2, pa3); pv_one<1>(o[1], vb, pa0, pa1, pa2, pa3); pv_one<2>(o[2], vb, pa0, pa1, pa2, pa3); pv_one<3>(o[3], vb, pa0, pa1, pa2, pa3);
}
__device__ __forceinline__ void partialSM(f32x16& p0, f32x16& p1, float& m_reg, float& alpha) {
  float pmax = p0[0];
#pragma unroll
  for (int r = 1; r < 16; ++r) pmax = fmaxf(pmax, p0[r]);
#pragma unroll
  for (int r = 0; r < 16; ++r) pmax = fmaxf(pmax, p1[r]);
  { auto rr = __builtin_amdgcn_permlane32_swap(__float_as_uint(pmax), __float_as_uint(pmax), false, false); pmax = fmaxf(__uint_as_float(rr[0]), __uint_as_float(rr[1])); }
  float mn;
  if (__builtin_expect(__all(pmax - m_reg <= THR), 1)) { mn = m_reg; alpha = 1.f; }
  else { mn = fmaxf(m_reg, pmax); alpha = __builtin_amdgcn_exp2f(m_reg - mn); m_reg = mn; }
#pragma unroll
  for (int r = 0; r < 16; ++r) p0[r] = __builtin_amdgcn_exp2f(p0[r] - mn);
#pragma unroll
  for (int r = 0; r < 16; ++r) p1[r] = __builtin_amdgcn_exp2f(p1[r] - mn);
}
__device__ __forceinline__ void finishSM(f32x16& p0, f32x16& p1, float alpha, float& l_reg, bf16x8& pa0, bf16x8& pa1, bf16x8& pa2, bf16x8& pa3) {
  float ps = 0.f;
#pragma unroll
  for (int r = 0; r < 16; ++r) ps += p0[r];
#pragma unroll
  for (int r = 0; r < 16; ++r) ps += p1[r];
  { auto rr = __builtin_amdgcn_permlane32_swap(__float_as_uint(ps), __float_as_uint(ps), false, false); ps = __uint_as_float(rr[0]) + __uint_as_float(rr[1]); }
  l_reg = l_reg * alpha + ps;
#define PK4(P, BASE, OUT) do { unsigned a0 = cvtpk(P[BASE + 0], P[BASE + 1]), a1 = cvtpk(P[BASE + 2], P[BASE + 3]);   \
    unsigned b0 = cvtpk(P[BASE + 4], P[BASE + 5]), b1 = cvtpk(P[BASE + 6], P[BASE + 7]);                              \
    auto r0 = __builtin_amdgcn_permlane32_swap(a0, b0, false, false); auto r1 = __builtin_amdgcn_permlane32_swap(a1, b1, false, false); \
    u32x4 w = {r0[0], r1[0], r0[1], r1[1]}; OUT = *reinterpret_cast<bf16x8*>(&w); } while (0)
  PK4(p0, 0, pa0); PK4(p0, 8, pa1); PK4(p1, 0, pa2); PK4(p1, 8, pa3);
#undef PK4
}
__device__ __forceinline__ void mask_tile(f32x16& p0, f32x16& p1, int qrel, int hi) {
  hi = opq(hi); qrel = opq(qrel);
#pragma unroll
  for (int r = 0; r < 16; ++r) { const int kv = crow(r, hi); if (kv > qrel) p0[r] = -INFINITY; if (kv + 32 > qrel) p1[r] = -INFINITY; }
}
#ifndef ROLEB_EXPR
#define ROLEB_EXPR (wid >= 4)
#endif
#ifndef ATT_MODE
#define ATT_MODE 2
#endif
#if ATT_MODE == 2
#define MLA_LOOP tile_loop_s<true, false>(o, l_reg, qr, Ksrc, 2048, KRsrc, 64, Vsrc, 2048, lds, NT, td, qlo, 0.f, 0.f, 0.f, wid, lane);
#define DIFF_LOOP tile_loop_s<false, true>(o, l_reg, qr, nullptr, 0, Ksrc + mp * 64, 1024, Vsrc, 1024, lds, NT, td, qlo, pq, ch, mhat0, wid, lane);
#else
#define MLA_LOOP tile_loop3<true, false>(o, l_reg, qr, Ksrc, 2048, KRsrc, 64, Vsrc, 2048, lds, NT, qlo >> 5, 0.f, 0.f, 0.f, wid, lane);
#define DIFF_LOOP tile_loop1d(o, l_reg, qr, Ksrc + mp * 64, 1024, Vsrc, 1024, lds, NT, td, qlo, pq, ch, mhat0, wid, lane);
#endif
struct Ptrs { const bf16 *QM, *KVM, *KR, *DQ, *DK, *DV, *GM, *GD; bf16* MIX; const int* pos; const float* gsub; };

#define ATT_RESC(O, a) do { if (__any((a) < 1.f)) { if (hi == 0) wsf[r32] = (a); asm volatile("s_waitcnt lgkmcnt(0)" ::: "memory"); \
    _Pragma("unroll") for (int d = 0; d < 4; ++d) _Pragma("unroll") for (int r = 0; r < 16; ++r) O[d][r] *= wsf[crow(r, hi)]; } } while (0)

__device__ __forceinline__ float rowmax16(const f32x16& p) {
  float a = fmaxf(fmaxf(p[0], p[1]), p[2]), b = fmaxf(fmaxf(p[3], p[4]), p[5]); a = fmaxf(fmaxf(a, p[6]), p[7]); b = fmaxf(fmaxf(b, p[8]), p[9]); a = fmaxf(fmaxf(a, p[10]), p[11]); b = fmaxf(fmaxf(b, p[12]), p[13]);
  float m = fmaxf(fmaxf(a, b), fmaxf(p[14], p[15]));
  auto rr = __builtin_amdgcn_permlane32_swap(__float_as_uint(m), __float_as_uint(m), false, false);
  return fmaxf(__uint_as_float(rr[0]), __uint_as_float(rr[1]));
}
template <bool FIRST>
__device__ __forceinline__ void sm_start(f32x16& p, float& mhat, float& alpha) {
  const float pmax = rowmax16(p);
  alpha = 1.f;
  if (FIRST || !__builtin_expect(__all(pmax <= THR), 1)) {
    const float dl = FIRST ? pmax : fmaxf(pmax, 0.f);
    mhat += dl; alpha = __builtin_amdgcn_exp2f(-dl);
#pragma unroll
    for (int r = 0; r < 16; ++r) p[r] -= dl;
  }
#pragma unroll
  for (int r = 0; r < 16; ++r) p[r] = __builtin_amdgcn_exp2f(p[r]);
}
__device__ __forceinline__ void sm_finish(const f32x16& p, float alpha, float& l_reg, bf16x8& pa0, bf16x8& pa1) {
  float ps = ((p[0] + p[1]) + (p[2] + p[3])) + ((p[4] + p[5]) + (p[6] + p[7])) + ((p[8] + p[9]) + (p[10] + p[11])) + ((p[12] + p[13]) + (p[14] + p[15]));
  { auto rr = __builtin_amdgcn_permlane32_swap(__float_as_uint(ps), __float_as_uint(ps), false, false); ps = __uint_as_float(rr[0]) + __uint_as_float(rr[1]); }
  l_reg = l_reg * alpha + ps;
#define PK4(P, BASE, OUT) do { unsigned a0 = cvtpk(P[BASE + 0], P[BASE + 1]), a1 = cvtpk(P[BASE + 2], P[BASE + 3]);   \
    unsigned b0 = cvtpk(P[BASE + 4], P[BASE + 5]), b1 = cvtpk(P[BASE + 6], P[BASE + 7]);                              \
    auto r0 = __builtin_amdgcn_permlane32_swap(a0, b0, false, false); auto r1 = __builtin_amdgcn_permlane32_swap(a1, b1, false, false); \
    u32x4 w = {r0[0], r1[0], r0[1], r1[1]}; OUT = *reinterpret_cast<bf16x8*>(&w); } while (0)
  PK4(p, 0, pa0); PK4(p, 8, pa1);
#undef PK4
}
__device__ __forceinline__ void mask_sub(f32x16& p, int qrel, int hi) {
  hi = opq(hi); qrel = opq(qrel);
#pragma unroll
  for (int r = 0; r < 16; ++r) if (crow(r, hi) > qrel) p[r] = -INFINITY;
}
typedef short v4i16_t __attribute__((ext_vector_type(4)));
__device__ __forceinline__ s16x4 vtr(int addr) { return __builtin_bit_cast(s16x4, __builtin_amdgcn_ds_read_tr16_b64_v4i16((ALAS v4i16_t*)(uintptr_t)(unsigned)addr)); }
template <int D0, int HALF, bool VIS> __device__ __forceinline__ void pv_half(f32x16& od, int vb, bf16x8 pa0, bf16x8 pa1) {
  s16x4 l0, h0, l1, h1;
  if (VIS) { l0 = vtr(vb + v_rd_off(D0, 2 * HALF, 0)); h0 = vtr(vb + v_rd_off(D0, 2 * HALF, 1)); l1 = vtr(vb + v_rd_off(D0, 2 * HALF + 1, 0)); h1 = vtr(vb + v_rd_off(D0, 2 * HALF + 1, 1)); }
  else { l0 = tr_read<v_rd_off(D0, 2 * HALF, 0)>(vb); h0 = tr_read<v_rd_off(D0, 2 * HALF, 1)>(vb); l1 = tr_read<v_rd_off(D0, 2 * HALF + 1, 0)>(vb); h1 = tr_read<v_rd_off(D0, 2 * HALF + 1, 1)>(vb);
    asm volatile("s_waitcnt lgkmcnt(0)" ::: "memory"); SBAR(); }
#define PK(L, H) (bf16x8){L[0], L[1], L[2], L[3], H[0], H[1], H[2], H[3]}
  od = __builtin_amdgcn_mfma_f32_32x32x16_bf16(pa0, PK(l0, h0), od, 0, 0, 0);
  od = __builtin_amdgcn_mfma_f32_32x32x16_bf16(pa1, PK(l1, h1), od, 0, 0, 0);
#undef PK
}
template <int HALF, bool VIS> __device__ __forceinline__ void pv_sub(f32x16* o, int vb, bf16x8 pa0, bf16x8 pa1) {
  pv_half<0, HALF, VIS>(o[0], vb, pa0, pa1); pv_half<1, HALF, VIS>(o[1], vb, pa0, pa1); pv_half<2, HALF, VIS>(o[2], vb, pa0, pa1); pv_half<3, HALF, VIS>(o[3], vb, pa0, pa1);
}
template <bool MLA, bool HAVE_REF>
__device__ __forceinline__ void tile_loop3(f32x16 (&o)[4], float& l_reg, const bf16x8* qr, const bf16* K256, int ldk256, const bf16* K128, int ldk128, const bf16* Vsrc, int ldv,
                                           ALAS char* lds, int NT, int sd, float pq, float ch, float mhat0, int wid, int lane) {
  const int r32 = lane & 31, hi = lane >> 5;
  ALAS float* wsf = (ALAS float*)(lds + WS_OFF) + wid * 64; ALAS float* posk = (ALAS float*)(lds + POSK_OFF);
  const unsigned ok0 = MLA ? off_k256(0, ldk256, wid, lane) : 0u, ok1 = MLA ? off_k256(1, ldk256, wid, lane) : 0u, okr = off_k128(ldk128, wid, lane), ov0 = off_v(0, ldv, wid, lane), ov1 = off_v(1, ldv, wid, lane);
#define DMA_KT(t) do { const int kb_ = ((t) & 1) * KBUF_BYTES; if (MLA) { const char* g_ = (const char*)(K256 + (size_t)(t) * KVBLK * ldk256); glds16(g_ + ok0, lds + kb_ + K_OFF + wid * 1024); glds16(g_ + ok1, lds + kb_ + K_OFF + (8 + wid) * 1024); } \
    glds16((const char*)(K128 + (size_t)(t) * KVBLK * ldk128) + okr, lds + kb_ + KR_OFF + wid * 1024); } while (0)
#define DMA_VT(t) do { const int vo_ = V_BASE + ((t) % 3) * VBUF_BYTES; const char* g_ = (const char*)(Vsrc + (size_t)(t) * KVBLK * ldv); glds16(g_ + ov0, lds + vo_ + wid * 1024); glds16(g_ + ov1, lds + vo_ + (8 + wid) * 1024); } while (0)
  DMA_KT(0); DMA_VT(0); DMA_KT(1); DMA_VT(1);
  float mhat = HAVE_REF ? mhat0 : 0.f; l_reg = 0.f; asm volatile("" : "+v"(mhat));
#pragma unroll
  for (int d = 0; d < 4; ++d) o[d] = f32x16{};
  const int vrb = (int)(uintptr_t)(lds + V_BASE) + v_rd_base(lane);
  const int ka = r32 * 256, ksw = (r32 & 7), kra = r32 * 128, krsw = (r32 >> 1) & 7;
  f32x16 pA, pB; float alA = 1.f, alB = 1.f; bf16x8 pa0, pa1;
#define INIT_C(P, s) do { if (MLA) { _Pragma("unroll") for (int r = 0; r < 16; ++r) P[r] = -mhat; } else { \
    _Pragma("unroll") for (int g = 0; g < 4; ++g) { const f32x4 a_ = *reinterpret_cast<const ALAS f32x4*>(posk + (s) * 32 + 8 * g + 4 * hi); \
      _Pragma("unroll") for (int j_ = 0; j_ < 4; ++j_) P[4 * g + j_] = -ch * fabsf(pq - a_[j_]) - mhat; } } } while (0)
#define QKT(P, s) do { const ALAS char* Kb = lds + (((s) >> 1) & 1) * KBUF_BYTES + K_OFF + ((s) & 1) * (32 * 256); const ALAS char* Kr = lds + (((s) >> 1) & 1) * KBUF_BYTES + KR_OFF + ((s) & 1) * (32 * 128); \
    if (MLA) { _Pragma("unroll") for (int d0 = 0; d0 < 8; ++d0) { const bf16x8 b0 = *reinterpret_cast<const ALAS bf16x8*>(Kb + ka + (((2 * d0 + hi) ^ ksw) << 4)); \
        P = __builtin_amdgcn_mfma_f32_32x32x16_bf16(b0, qr[d0], P, 0, 0, 0); } } \
    _Pragma("unroll") for (int d0 = 0; d0 < 4; ++d0) { const bf16x8 b0 = *reinterpret_cast<const ALAS bf16x8*>(Kr + kra + (((2 * d0 + hi) ^ krsw) << 4)); \
      P = __builtin_amdgcn_mfma_f32_32x32x16_bf16(b0, qr[(MLA ? 8 : 0) + d0], P, 0, 0, 0); } } while (0)
#define STEP(Pn, Po, alN, alO, s, HALFO, G) do { \
    if (!(G) || (s) - 1 <= sd) { \
      SBAR(); if (!(G) || (s) <= sd) QKT(Pn, (s)); \
      sm_finish(Po, alO, l_reg, pa0, pa1); SBAR(); \
      pv_sub<HALFO, false>(o, vrb + ((((s) - 1) >> 1) % 3) * VBUF_BYTES, pa0, pa1); \
      if (!(G) || (s) <= sd) { if ((G) && (s) == sd) mask_sub(Pn, r32, hi); sm_start<false>(Pn, mhat, alN); ATT_RESC(o, alN); if (!(G) || (s) + 1 <= sd) INIT_C(Po, (s) + 1); } \
    } } while (0)
  asm volatile("s_waitcnt vmcnt(0)" ::: "memory"); __syncthreads();
  INIT_C(pA, 0); QKT(pA, 0); if (sd == 0) mask_sub(pA, r32, hi);
  sm_start<!HAVE_REF>(pA, mhat, alA); alA = 1.f;
  if (1 <= sd) INIT_C(pB, 1);
  STEP(pB, pA, alB, alA, 1, 0, 1);
  for (int j = 1; j < NT; ++j) {
    asm volatile("s_waitcnt vmcnt(0)" ::: "memory"); __syncthreads();
    if (j + 1 < NT) { DMA_KT(j + 1); DMA_VT(j + 1); }
    STEP(pA, pB, alA, alB, 2 * j, 1, 1);
    STEP(pB, pA, alB, alA, 2 * j + 1, 0, 1);
  }
  { const int s = 2 * NT; if (s - 1 <= sd) { sm_finish(pB, alB, l_reg, pa0, pa1); SBAR(); pv_sub<1, false>(o, vrb + (((s - 1) >> 1) % 3) * VBUF_BYTES, pa0, pa1); } }
  __syncthreads();
#undef STEP
#undef QKT
#undef INIT_C
#undef DMA_KT
#undef DMA_VT
}

__device__ __forceinline__ float rowmax32(const f32x16& p0, const f32x16& p1) {
  float a = fmaxf(fmaxf(p0[0], p0[1]), p1[0]), b = fmaxf(fmaxf(p0[2], p0[3]), p1[1]); a = fmaxf(fmaxf(a, p1[2]), p1[3]);
#pragma unroll
  for (int r = 4; r < 16; r += 4) { a = fmaxf(fmaxf(a, p0[r]), p0[r + 1]); b = fmaxf(fmaxf(b, p0[r + 2]), p0[r + 3]); a = fmaxf(fmaxf(a, p1[r]), p1[r + 1]); b = fmaxf(fmaxf(b, p1[r + 2]), p1[r + 3]); }
  float m = fmaxf(a, b);
  auto rr = __builtin_amdgcn_permlane32_swap(__float_as_uint(m), __float_as_uint(m), false, false);
  return fmaxf(__uint_as_float(rr[0]), __uint_as_float(rr[1]));
}
__device__ __forceinline__ void sm_start2(f32x16& p0, f32x16& p1, float& mhat, float& alpha) {
  const float pmax = rowmax32(p0, p1);
  alpha = 1.f;
  if (!__builtin_expect(__all(pmax <= THR), 1)) {
    const float dl = fmaxf(pmax, 0.f);
    mhat += dl; alpha = __builtin_amdgcn_exp2f(-dl);
#pragma unroll
    for (int r = 0; r < 16; ++r) { p0[r] -= dl; p1[r] -= dl; }
  }
#pragma unroll
  for (int r = 0; r < 16; ++r) p0[r] = __builtin_amdgcn_exp2f(p0[r]);
}
__device__ __forceinline__ void sm_finish2(f32x16& p0, f32x16& p1, float alpha, float& l_reg, bf16x8& pa0, bf16x8& pa1, bf16x8& pa2, bf16x8& pa3) {
#pragma unroll
  for (int r = 0; r < 16; ++r) p1[r] = __builtin_amdgcn_exp2f(p1[r]);
  float ps = 0.f;
#pragma unroll
  for (int r = 0; r < 16; ++r) ps += p0[r];
#pragma unroll
  for (int r = 0; r < 16; ++r) ps += p1[r];
  { auto rr = __builtin_amdgcn_permlane32_swap(__float_as_uint(ps), __float_as_uint(ps), false, false); ps = __uint_as_float(rr[0]) + __uint_as_float(rr[1]); }
  l_reg = l_reg * alpha + ps;
#define PK4(P, BASE, OUT) do { unsigned a0 = cvtpk(P[BASE + 0], P[BASE + 1]), a1 = cvtpk(P[BASE + 2], P[BASE + 3]);   \
    unsigned b0 = cvtpk(P[BASE + 4], P[BASE + 5]), b1 = cvtpk(P[BASE + 6], P[BASE + 7]);                              \
    auto r0 = __builtin_amdgcn_permlane32_swap(a0, b0, false, false); auto r1 = __builtin_amdgcn_permlane32_swap(a1, b1, false, false); \
    u32x4 w = {r0[0], r1[0], r0[1], r1[1]}; OUT = *reinterpret_cast<bf16x8*>(&w); } while (0)
  PK4(p0, 0, pa0); PK4(p0, 8, pa1); PK4(p1, 0, pa2); PK4(p1, 8, pa3);
#undef PK4
}
__device__ __forceinline__ void tile_loop2d(f32x16 (&o)[4], float& l_reg, const bf16x8* qr, const bf16* K128, int ldk128, const bf16* Vsrc, int ldv,
                                            ALAS char* lds, int NT, int td, int qlo, float pq, float ch, float mhat0, int wid, int lane) {
  const int r32 = lane & 31, hi = lane >> 5;
  ALAS float* wsf = (ALAS float*)(lds + WS_OFF) + wid * 64; ALAS float* posk = (ALAS float*)(lds + POSK_OFF);
  const unsigned okr = off_k128(ldk128, wid, lane), ov0 = off_v(0, ldv, wid, lane), ov1 = off_v(1, ldv, wid, lane);
#define DMA_KT(t) glds16((const char*)(K128 + (size_t)(t) * KVBLK * ldk128) + okr, lds + ((t) & 1) * KBUF_BYTES + KR_OFF + wid * 1024)
#define DMA_VT(t) do { const int vo_ = V_BASE + ((t) & 1) * VBUF_BYTES; const char* g_ = (const char*)(Vsrc + (size_t)(t) * KVBLK * ldv); glds16(g_ + ov0, lds + vo_ + wid * 1024); glds16(g_ + ov1, lds + vo_ + (8 + wid) * 1024); } while (0)
  DMA_KT(0); DMA_VT(0); DMA_KT(1);
  float mhat = mhat0; l_reg = 0.f;
  ALAS char* qst = lds + (wid >> 2) * KBUF_BYTES + K_OFF + (wid & 3) * 4096 + lane * 16;
#pragma unroll
  for (int d0 = 0; d0 < 4; ++d0) *reinterpret_cast<ALAS bf16x8*>(qst + d0 * 1024) = qr[d0];
#pragma unroll
  for (int d = 0; d < 4; ++d) o[d] = f32x16{};
  const int vrb = (int)(uintptr_t)(lds + V_BASE) + v_rd_base(lane);
  const int kra = r32 * 128, krsw = (r32 >> 1) & 7;
  f32x16 pA0, pA1, pB0, pB1; float alA = 1.f, alB = 1.f; bf16x8 pa0, pa1, pa2, pa3;
#define INIT_C(P0, P1, t) do { _Pragma("unroll") for (int g = 0; g < 4; ++g) { const f32x4 a_ = *reinterpret_cast<const ALAS f32x4*>(posk + (t) * KVBLK + 8 * g + 4 * hi); \
      _Pragma("unroll") for (int j_ = 0; j_ < 4; ++j_) P0[4 * g + j_] = -ch * fabsf(pq - a_[j_]) - mhat; } SBAR(); \
    _Pragma("unroll") for (int g = 0; g < 4; ++g) { const f32x4 c_ = *reinterpret_cast<const ALAS f32x4*>(posk + (t) * KVBLK + 32 + 8 * g + 4 * hi); \
      _Pragma("unroll") for (int j_ = 0; j_ < 4; ++j_) P1[4 * g + j_] = -ch * fabsf(pq - c_[j_]) - mhat; } } while (0)
#define QKT(P0, P1, t) do { const ALAS char* Kr = lds + ((t) & 1) * KBUF_BYTES + KR_OFF; \
    _Pragma("unroll") for (int d0 = 0; d0 < 4; ++d0) { const int off = kra + (((2 * d0 + hi) ^ krsw) << 4); \
      const bf16x8 b0 = *reinterpret_cast<const ALAS bf16x8*>(Kr + off), b1 = *reinterpret_cast<const ALAS bf16x8*>(Kr + off + 32 * 128), q_ = *reinterpret_cast<const ALAS bf16x8*>(qst + d0 * 1024); \
      P0 = __builtin_amdgcn_mfma_f32_32x32x16_bf16(b0, q_, P0, 0, 0, 0); P1 = __builtin_amdgcn_mfma_f32_32x32x16_bf16(b1, q_, P1, 0, 0, 0); } } while (0)
#define STEP(Pn0, Pn1, Po0, Po1, alN, alO, j, G) do { \
    if ((j) + 1 < NT) DMA_KT((j) + 1); if ((j) < NT) DMA_VT((j)); \
    if (!(G) || (j) - 1 <= td) { \
      SBAR(); if (!(G) || (j) <= td) QKT(Pn0, Pn1, (j)); \
      sm_finish2(Po0, Po1, alO, l_reg, pa0, pa1, pa2, pa3); SBAR(); \
      pv_d0(o, vrb + (((j) - 1) & 1) * VBUF_BYTES, pa0, pa1, pa2, pa3); \
      if (!(G) || (j) <= td) { if ((G) && (j) == td) mask_tile(Pn0, Pn1, qlo + r32 - (j) * KVBLK, hi); sm_start2(Pn0, Pn1, mhat, alN); ATT_RESC(o, alN); if (!(G) || (j) + 1 <= td) INIT_C(Po0, Po1, (j) + 1); } \
    } \
    asm volatile("s_waitcnt vmcnt(0)" ::: "memory"); __syncthreads(); \
  } while (0)
  asm volatile("s_waitcnt vmcnt(0)" ::: "memory"); __syncthreads();
  INIT_C(pA0, pA1, 0); QKT(pA0, pA1, 0); if (td == 0) mask_tile(pA0, pA1, qlo + r32, hi);
  sm_start2(pA0, pA1, mhat, alA); alA = 1.f;
  if (1 <= td) INIT_C(pB0, pB1, 1);
  const int jm = NT - 5;
  int j = 1;
  for (; j + 1 <= jm; j += 2) {
    STEP(pB0, pB1, pA0, pA1, alB, alA, j, 0);
    STEP(pA0, pA1, pB0, pB1, alA, alB, j + 1, 0);
  }
  for (; j < NT; j += 2) {
    STEP(pB0, pB1, pA0, pA1, alB, alA, j, 1);
    STEP(pA0, pA1, pB0, pB1, alA, alB, j + 1, 1);
  }
#undef STEP
#undef QKT
#undef INIT_C
#undef DMA_KT
#undef DMA_VT
}

__device__ __forceinline__ void tile_loop1d(f32x16 (&o)[4], float& l_reg, const bf16x8* qr, const bf16* K128, int ldk128, const bf16* Vsrc, int ldv,
                                            ALAS char* lds, int NT, int td, int qlo, float pq, float ch, float mhat0, int wid, int lane) {
  const int r32 = lane & 31, hi = lane >> 5;
  ALAS float* wsf = (ALAS float*)(lds + WS_OFF) + wid * 64; ALAS float* posk = (ALAS float*)(lds + POSK_OFF);
  const unsigned okr = off_k128(ldk128, wid, lane), ov0 = off_v(0, ldv, wid, lane), ov1 = off_v(1, ldv, wid, lane);
#define DMA_KV(t) do { glds16((const char*)(K128 + (size_t)(t) * KVBLK * ldk128) + okr, lds + ((t) & 1) * KBUF_BYTES + KR_OFF + wid * 1024); \
    const int vo_ = V_BASE + ((t) & 1) * VBUF_BYTES; const char* g_ = (const char*)(Vsrc + (size_t)(t) * KVBLK * ldv); glds16(g_ + ov0, lds + vo_ + wid * 1024); glds16(g_ + ov1, lds + vo_ + (8 + wid) * 1024); } while (0)
  DMA_KV(0);
  float mhat = mhat0; l_reg = 0.f;
#pragma unroll
  for (int d = 0; d < 4; ++d) o[d] = f32x16{};
  const int vrb = (int)(uintptr_t)(lds + V_BASE) + v_rd_base(lane);
  const int kra = r32 * 128, krsw = (r32 >> 1) & 7;
  asm volatile("s_waitcnt vmcnt(0)" ::: "memory"); __syncthreads();
  for (int t = 0; t < NT; ++t) {
    if (t + 1 < NT) DMA_KV(t + 1);
    if (t <= td) {
      f32x16 p0, p1;
#pragma unroll
      for (int g = 0; g < 4; ++g) { const f32x4 a_ = *reinterpret_cast<const ALAS f32x4*>(posk + t * KVBLK + 8 * g + 4 * hi), c_ = *reinterpret_cast<const ALAS f32x4*>(posk + t * KVBLK + 32 + 8 * g + 4 * hi);
#pragma unroll
        for (int j = 0; j < 4; ++j) { p0[4 * g + j] = -ch * fabsf(pq - a_[j]) - mhat; p1[4 * g + j] = -ch * fabsf(pq - c_[j]) - mhat; } }
      const ALAS char* Kr = lds + (t & 1) * KBUF_BYTES + KR_OFF;
#pragma unroll
      for (int d0 = 0; d0 < 4; ++d0) { const int off = kra + (((2 * d0 + hi) ^ krsw) << 4);
        const bf16x8 b0 = *reinterpret_cast<const ALAS bf16x8*>(Kr + off), b1 = *reinterpret_cast<const ALAS bf16x8*>(Kr + off + 32 * 128);
        p0 = __builtin_amdgcn_mfma_f32_32x32x16_bf16(b0, qr[d0], p0, 0, 0, 0); p1 = __builtin_amdgcn_mfma_f32_32x32x16_bf16(b1, qr[d0], p1, 0, 0, 0); }
      if (t == td) mask_tile(p0, p1, qlo + r32 - t * KVBLK, hi);
      float alpha; bf16x8 pa0, pa1, pa2, pa3;
      sm_start2(p0, p1, mhat, alpha); ATT_RESC(o, alpha); sm_finish2(p0, p1, alpha, l_reg, pa0, pa1, pa2, pa3); SBAR();
      pv_d0(o, vrb + (t & 1) * VBUF_BYTES, pa0, pa1, pa2, pa3);
    }
    asm volatile("s_waitcnt vmcnt(0)" ::: "memory"); __syncthreads();
  }
#undef DMA_KV
}

__device__ __forceinline__ void sm_start2f(f32x16& p0, f32x16& p1, float& mhat, float& alpha, bool first  ) {
  const float pmax = rowmax32(p0, p1);
  alpha = 1.f;
  if (first || !__builtin_expect(__all(pmax <= THR), 1)) {
    const float dl = first ? pmax : fmaxf(pmax, 0.f);
    mhat += dl; alpha = first ? 1.f : __builtin_amdgcn_exp2f(-dl);
#pragma unroll
    for (int r = 0; r < 16; ++r) { p0[r] -= dl; p1[r] -= dl; }
  }
#pragma unroll
  for (int r = 0; r < 16; ++r) p0[r] = __builtin_amdgcn_exp2f(p0[r]);
}
template <bool MLA, bool HAVE_REF>
__device__ __forceinline__ void tile_loop_s(f32x16 (&o)[4], float& l_reg, const bf16x8* qr, const bf16* K256, int ldk256, const bf16* K128, int ldk128, const bf16* Vsrc, int ldv,
                                            ALAS char* lds, int NT, int td, int qlo, float pq, float ch, float mhat0, int wid, int lane) {
  const int r32 = lane & 31, hi = lane >> 5;
  ALAS float* wsf = (ALAS float*)(lds + WS_OFF) + wid * 64; ALAS float* posk = (ALAS float*)(lds + POSK_OFF);
  const unsigned ok0 = MLA ? off_k256(0, ldk256, wid, lane) : 0u, ok1 = MLA ? off_k256(1, ldk256, wid, lane) : 0u, okr = off_k128(ldk128, wid, lane), ov0 = off_v(0, ldv, wid, lane), ov1 = off_v(1, ldv, wid, lane);
#define DMA_KV(t) do { const int kb_ = ((t) & 1) * KBUF_BYTES; if (MLA) { const char* g_ = (const char*)(K256 + (size_t)(t) * KVBLK * ldk256); glds16(g_ + ok0, lds + kb_ + K_OFF + wid * 1024); glds16(g_ + ok1, lds + kb_ + K_OFF + (8 + wid) * 1024); } \
    glds16((const char*)(K128 + (size_t)(t) * KVBLK * ldk128) + okr, lds + kb_ + KR_OFF + wid * 1024); \
    const int vo_ = V_BASE + ((t) % 3) * VBUF_BYTES; const char* gv_ = (const char*)(Vsrc + (size_t)(t) * KVBLK * ldv); glds16(gv_ + ov0, lds + vo_ + wid * 1024); glds16(gv_ + ov1, lds + vo_ + (8 + wid) * 1024); } while (0)
  DMA_KV(0);
  float mhat = HAVE_REF ? mhat0 : 0.f; l_reg = 0.f; asm volatile("" : "+v"(mhat));
#pragma unroll
  for (int d = 0; d < 4; ++d) o[d] = f32x16{};
  const int vrb = (int)(uintptr_t)(lds + V_BASE) + v_rd_base(lane);
  const int ka = r32 * 256, ksw = (r32 & 7), kra = r32 * 128, krsw = (r32 >> 1) & 7;
  const bool roleB = ROLEB_EXPR;
  bf16x8 pa0, pa1, pa2, pa3;
#define SCORE(t) do { f32x16 p0, p1; \
    if (MLA) { _Pragma("unroll") for (int r = 0; r < 16; ++r) { p0[r] = -mhat; p1[r] = -mhat; } } else { \
      _Pragma("unroll") for (int g = 0; g < 4; ++g) { const f32x4 a_ = *reinterpret_cast<const ALAS f32x4*>(posk + (t) * KVBLK + 8 * g + 4 * hi), c_ = *reinterpret_cast<const ALAS f32x4*>(posk + (t) * KVBLK + 32 + 8 * g + 4 * hi); \
        _Pragma("unroll") for (int j_ = 0; j_ < 4; ++j_) { p0[4 * g + j_] = -ch * fabsf(pq - a_[j_]) - mhat; p1[4 * g + j_] = -ch * fabsf(pq - c_[j_]) - mhat; } } } \
    const ALAS char* Kb = lds + ((t) & 1) * KBUF_BYTES + K_OFF; const ALAS char* Kr = lds + ((t) & 1) * KBUF_BYTES + KR_OFF; \
    if (MLA) { _Pragma("unroll") for (int d0 = 0; d0 < 8; ++d0) { const int off = ka + (((2 * d0 + hi) ^ ksw) << 4); \
        const bf16x8 b0 = *reinterpret_cast<const ALAS bf16x8*>(Kb + off), b1 = *reinterpret_cast<const ALAS bf16x8*>(Kb + off + 32 * 256); \
        p0 = __builtin_amdgcn_mfma_f32_32x32x16_bf16(b0, qr[d0], p0, 0, 0, 0); p1 = __builtin_amdgcn_mfma_f32_32x32x16_bf16(b1, qr[d0], p1, 0, 0, 0); } } \
    _Pragma("unroll") for (int d0 = 0; d0 < 4; ++d0) { const int off = kra + (((2 * d0 + hi) ^ krsw) << 4); \
      const bf16x8 b0 = *reinterpret_cast<const ALAS bf16x8*>(Kr + off), b1 = *reinterpret_cast<const ALAS bf16x8*>(Kr + off + 32 * 128); \
      p0 = __builtin_amdgcn_mfma_f32_32x32x16_bf16(b0, qr[(MLA ? 8 : 0) + d0], p0, 0, 0, 0); p1 = __builtin_amdgcn_mfma_f32_32x32x16_bf16(b1, qr[(MLA ? 8 : 0) + d0], p1, 0, 0, 0); } \
    if ((t) == td) mask_tile(p0, p1, qlo + r32 - (t) * KVBLK, hi); \
    float alpha; sm_start2f(p0, p1, mhat, alpha, !HAVE_REF && (t) == 0); ATT_RESC(o, alpha); sm_finish2(p0, p1, alpha, l_reg, pa0, pa1, pa2, pa3); } while (0)
  asm volatile("s_waitcnt vmcnt(0)" ::: "memory"); __syncthreads();
  if (!roleB) {
    for (int t = 0; t <= NT; ++t) {
      if (t + 1 < NT) DMA_KV(t + 1);
      if (t <= td && t < NT) { SCORE(t); SBAR(); pv_d0(o, vrb + (t % 3) * VBUF_BYTES, pa0, pa1, pa2, pa3); }
      asm volatile("s_waitcnt vmcnt(0)" ::: "memory"); __syncthreads();
    }
  } else {
    for (int t = 0; t <= NT; ++t) {
      if (t + 1 < NT) DMA_KV(t + 1);
      if (t >= 1 && t - 1 <= td) { pv_d0(o, vrb + ((t - 1) % 3) * VBUF_BYTES, pa0, pa1, pa2, pa3); SBAR(); }
      if (t <= td && t < NT) { SCORE(t); }
      asm volatile("s_waitcnt vmcnt(0)" ::: "memory"); __syncthreads();
    }
  }
#undef SCORE
#undef DMA_KV
}

__device__ __forceinline__ float bflo(unsigned u) { return __uint_as_float(u << 16); }
__device__ __forceinline__ float bfhi(unsigned u) { return __uint_as_float(u & 0xffff0000u); }
__device__ __forceinline__ void mla_unit(const Ptrs& P, int b, int h, int qb, ALAS char* lds) {
  const int tid = opq(threadIdx.x), lane = tid & 63, r32 = lane & 31, hi = lane >> 5; const int wid = __builtin_amdgcn_readfirstlane(tid >> 6);
  const size_t rowbase = (size_t)b * SEQ; const int q0 = qb * 256, qlo = q0 + wid * QBLK, NT = 4 * (qb + 1), td = qlo >> 6;
  const bf16* Ksrc = P.KVM + rowbase * 2048 + h * 256; const bf16* Vsrc = Ksrc + 128; const bf16* KRsrc = P.KR + rowbase * 64;
  ALAS float* wsf = (ALAS float*)(lds + WS_OFF) + wid * 64;
  bf16x8 qr[12];
  { const bf16* Qw = P.QM + (rowbase + qlo + r32) * 1536 + h * 192 + hi * 8;
#pragma unroll
    for (int d0 = 0; d0 < 12; ++d0) qr[d0] = *reinterpret_cast<const bf16x8*>(Qw + d0 * 16); }
  f32x16 o[4]; float l_reg;
  MLA_LOOP
  { const int hi2 = opq(hi), rr = opq(r32), ln = opq(lane);
    ALAS bf16* stg = (ALAS bf16*)(lds + wid * 8192);
    if (hi2 == 0) wsf[32 + rr] = l_reg; asm volatile("s_waitcnt lgkmcnt(0)" ::: "memory");
#pragma unroll
    for (int r = 0; r < 16; ++r) { const int cr = (r & 3) + 8 * (r >> 2) + 4 * hi2; const float rli = __builtin_amdgcn_rcpf(wsf[32 + cr]);
#pragma unroll
      for (int d0 = 0; d0 < 4; ++d0) stg[cr * 128 + d0 * 32 + rr] = f2bf(o[d0][r] * rli); }
    asm volatile("s_waitcnt lgkmcnt(0)" ::: "memory");
    const int c8 = (ln & 15) * 8; const size_t grow = rowbase + qlo + (ln >> 4);
    const bf16* gp = P.GM + grow * 1024 + h * 128 + c8; bf16* mp_ = P.MIX + grow * 2048 + h * 128 + c8;
#pragma unroll
    for (int i = 0; i < 8; ++i) { const u32x4 ov = *reinterpret_cast<const ALAS u32x4*>(stg + (i * 4 + (ln >> 4)) * 128 + c8); const u32x4 gv = *reinterpret_cast<const u32x4*>(gp + (size_t)i * 4 * 1024);
      u32x4 w; w.x = cvtpk(bflo(ov.x) * bflo(gv.x), bfhi(ov.x) * bfhi(gv.x)); w.y = cvtpk(bflo(ov.y) * bflo(gv.y), bfhi(ov.y) * bfhi(gv.y)); w.z = cvtpk(bflo(ov.z) * bflo(gv.z), bfhi(ov.z) * bfhi(gv.z)); w.w = cvtpk(bflo(ov.w) * bflo(gv.w), bfhi(ov.w) * bfhi(gv.w));
      *reinterpret_cast<u32x4*>(mp_ + (size_t)i * 4 * 2048) = w; } }
  asm volatile("s_waitcnt lgkmcnt(0)" ::: "memory"); __syncthreads();
}

__device__ __forceinline__ void diff_unit(const Ptrs& P, int b, int h, int qb, ALAS char* lds, float lam, float* park) {
  const int tid = opq(threadIdx.x), lane = tid & 63, r32 = lane & 31, hi = lane >> 5; const int wid = __builtin_amdgcn_readfirstlane(tid >> 6);
  const size_t rowbase = (size_t)b * SEQ; const int q0 = qb * 256, qlo = q0 + wid * QBLK, NT = 4 * (qb + 1), td = qlo >> 6;
  const bf16* Ksrc = P.DK + rowbase * 1024 + h * 128; const bf16* Vsrc = P.DV + rowbase * 1024 + h * 128;
  ALAS float* wsf = (ALAS float*)(lds + WS_OFF) + wid * 64; ALAS float* posk = (ALAS float*)(lds + POSK_OFF);
#pragma unroll 1
  for (int i = tid; i < q0 + 256; i += NW * 64) posk[i] = (float)P.pos[rowbase + i];
  const float pq = (float)P.pos[rowbase + qlo + r32];
  const float ch = __builtin_amdgcn_exp2f(-(float)(h + 1)) * LOG2E;
#pragma unroll 1
  for (int mp = 0; mp < 2; ++mp) {
    bf16x8 qr[4];
    { const bf16* Qw = P.DQ + (rowbase + qlo + r32) * 1024 + h * 128 + mp * 64 + hi * 8;
#pragma unroll
      for (int d0 = 0; d0 < 4; ++d0) qr[d0] = *reinterpret_cast<const bf16x8*>(Qw + d0 * 16); }
    float mhat0;
    { f32x16 pd; const int hi3 = opq(hi), r3 = opq(r32);
#pragma unroll
      for (int r = 0; r < 16; ++r) { const int kk = crow(r, hi3); pd[r] = (kk > r3) ? -INFINITY : -ch * fabsf(pq - (float)P.pos[rowbase + qlo + kk]); }
      const bf16* Kd = Ksrc + mp * 64 + (size_t)(qlo + r3) * 1024 + hi3 * 8;
#pragma unroll
      for (int d0 = 0; d0 < 4; ++d0) { const bf16x8 kf = *reinterpret_cast<const bf16x8*>(Kd + d0 * 16); pd = __builtin_amdgcn_mfma_f32_32x32x16_bf16(kf, qr[d0], pd, 0, 0, 0); }
      mhat0 = rowmax16(pd); }
    f32x16 o[4]; float l_reg;
    DIFF_LOOP
    const int hi2 = opq(hi), rr = opq(r32), ln = opq(lane);
    if (hi2 == 0) wsf[32 + rr] = l_reg; asm volatile("s_waitcnt lgkmcnt(0)" ::: "memory");
    f32x4* pk4 = reinterpret_cast<f32x4*>(park) + ln;
    if (mp == 0) {
#pragma unroll
      for (int g = 0; g < 4; ++g) { const int crb = 8 * g + 4 * hi2; const f32x4 rl = *reinterpret_cast<const ALAS f32x4*>(wsf + 32 + crb);
#pragma unroll
        for (int d0 = 0; d0 < 4; ++d0) { f32x4 v; v[0] = o[d0][4 * g] * __builtin_amdgcn_rcpf(rl[0]); v[1] = o[d0][4 * g + 1] * __builtin_amdgcn_rcpf(rl[1]); v[2] = o[d0][4 * g + 2] * __builtin_amdgcn_rcpf(rl[2]); v[3] = o[d0][4 * g + 3] * __builtin_amdgcn_rcpf(rl[3]);
          pk4[(d0 * 4 + g) * 64] = v; } }
    } else {
      ALAS bf16* stg = (ALAS bf16*)(lds + wid * 8192);
#pragma unroll
      for (int g = 0; g < 4; ++g) { const int crb = 8 * g + 4 * hi2; const f32x4 rl = *reinterpret_cast<const ALAS f32x4*>(wsf + 32 + crb);
#pragma unroll
        for (int d0 = 0; d0 < 4; ++d0) { const f32x4 o1 = pk4[(d0 * 4 + g) * 64];
#pragma unroll
          for (int j = 0; j < 4; ++j) stg[(crb + j) * 128 + d0 * 32 + rr] = f2bf(o1[j] - o[d0][4 * g + j] * (lam * __builtin_amdgcn_rcpf(rl[j]))); } }
      asm volatile("s_waitcnt lgkmcnt(0)" ::: "memory");
      const int c8 = (ln & 15) * 8; const size_t grow = rowbase + qlo + (ln >> 4);
      const bf16* gp = P.GD + grow * 1024 + h * 128 + c8; bf16* mp_ = P.MIX + grow * 2048 + 1024 + h * 128 + c8;
      const f32x4 ga = *reinterpret_cast<const f32x4*>(P.gsub + c8) * 0.8f, gb = *reinterpret_cast<const f32x4*>(P.gsub + c8 + 4) * 0.8f;
#pragma unroll
      for (int i = 0; i < 8; ++i) { const u32x4 ov = *reinterpret_cast<const ALAS u32x4*>(stg + (i * 4 + (ln >> 4)) * 128 + c8); const u32x4 gv = *reinterpret_cast<const u32x4*>(gp + (size_t)i * 4 * 1024);
        float v[8] = {bflo(ov.x), bfhi(ov.x), bflo(ov.y), bfhi(ov.y), bflo(ov.z), bfhi(ov.z), bflo(ov.w), bfhi(ov.w)};
        float ss = ((v[0] * v[0] + v[1] * v[1]) + (v[2] * v[2] + v[3] * v[3])) + ((v[4] * v[4] + v[5] * v[5]) + (v[6] * v[6] + v[7] * v[7]));
        ss += __shfl_xor(ss, 1); ss += __shfl_xor(ss, 2); ss += __shfl_xor(ss, 4); ss += __shfl_xor(ss, 8);
        const float rn = 1.0f / sqrtf(ss * (1.0f / 128.0f) + 1e-6f);
        u32x4 w; w.x = cvtpk(v[0] * rn * ga[0] * bflo(gv.x), v[1] * rn * ga[1] * bfhi(gv.x)); w.y = cvtpk(v[2] * rn * ga[2] * bflo(gv.y), v[3] * rn * ga[3] * bfhi(gv.y));
        w.z = cvtpk(v[4] * rn * gb[0] * bflo(gv.z), v[5] * rn * gb[1] * bfhi(gv.z)); w.w = cvtpk(v[6] * rn * gb[2] * bflo(gv.w), v[7] * rn * gb[3] * bfhi(gv.w));
        *reinterpret_cast<u32x4*>(mp_ + (size_t)i * 4 * 2048) = w; }
    }
    asm volatile("s_waitcnt vmcnt(0) lgkmcnt(0)" ::: "memory"); __syncthreads();
  }
}
#undef ATT_RESC
#undef SBAR
}

#define GAS __attribute__((address_space(1)))
#define LAS __attribute__((address_space(3)))
typedef unsigned short bf16;
typedef unsigned v4u __attribute__((ext_vector_type(4)));
typedef float f32x4 __attribute__((ext_vector_type(4)));
typedef short bf16x8 __attribute__((ext_vector_type(8)));
typedef GAS unsigned gu32;
typedef GAS unsigned long long gu64;
#define RLX_AGENT __ATOMIC_RELAXED, __HIP_MEMORY_SCOPE_AGENT
#define LDS_WAIT() asm volatile("s_waitcnt lgkmcnt(0)" ::: "memory")
#define VM_WAIT() asm volatile("s_waitcnt vmcnt(0)" ::: "memory")
__device__ __forceinline__ unsigned long long rt() { return __builtin_amdgcn_s_memrealtime(); }
__device__ __forceinline__ unsigned f2bf(float f) { unsigned u = __builtin_bit_cast(unsigned, f); return (u + 0x7fffu + ((u >> 16) & 1u)) >> 16; }
__device__ __forceinline__ unsigned pk2(float lo, float hi) { return f2bf(lo) | (f2bf(hi) << 16); }

#define XB_TMO      128
#define XB_XCNT(j)  (256  + 64 * (j))
#define XB_XSUB(j)  (1280 + 64 * (j))
#define XB_XGEN(j)  (2304 + 64 * (j))
#define XB_TOP      3328
#define XB_TOPGEN   3392
#define XCD_BAR_WORDS 3456
#define XB_SPIN_CAP (1u << 18)

__device__ __forceinline__ unsigned xb_ld(unsigned* p)              { return __hip_atomic_load(p, __ATOMIC_RELAXED, __HIP_MEMORY_SCOPE_AGENT); }
__device__ __forceinline__ unsigned xb_add(unsigned* p, unsigned v) { return __hip_atomic_fetch_add(p, v, __ATOMIC_RELAXED, __HIP_MEMORY_SCOPE_AGENT); }
__device__ __forceinline__ unsigned xb_xcc_id() { return (unsigned)__builtin_amdgcn_s_getreg((3 << 11) | 20) & 0xFu; }
#define XB_SPIN(cond, bar) do { unsigned _sp = 0; while (cond) { __builtin_amdgcn_s_sleep(1); \
    if ((++_sp & 255u) == 0u) { if (xb_ld(&(bar)[XB_TMO])) break; if (_sp > XB_SPIN_CAP) { atomicAdd(&(bar)[XB_TMO], 1u); break; } } } } while (0)

struct XcdBarrier {
    unsigned* bar; unsigned x;
    volatile LAS unsigned* st;
};

__device__ __forceinline__ XcdBarrier xcd_barrier_post(unsigned* bar, volatile LAS unsigned* st) {
    XcdBarrier b; b.bar = bar; b.x = xb_xcc_id(); b.st = st;
    if (threadIdx.x == 0) (void)xb_add(&bar[XB_XCNT(b.x)], 1u);
    return b;
}
__device__ __forceinline__ void xcd_barrier_complete(unsigned* bar, unsigned x, unsigned& nloc, unsigned& nx) {
    const unsigned G = gridDim.x * gridDim.y * gridDim.z;
    unsigned sum, cnt, mine, sp = 0u;
    for (;;) {
        sum = 0u; cnt = 0u; mine = 0u;
#pragma unroll
        for (unsigned j = 0; j < 16; ++j) { const unsigned c = xb_ld(&bar[XB_XCNT(j)]); sum += c; cnt += (c > 0u) ? 1u : 0u; mine = (j == x) ? c : mine; }
        if (sum == G) break;
        __builtin_amdgcn_s_sleep(1);
        if ((++sp & 255u) == 0u) { if (xb_ld(&bar[XB_TMO])) break; if (sp > XB_SPIN_CAP) { atomicAdd(&bar[XB_TMO], 1u); break; } }
    }
    nloc = mine > 0u ? mine : 1u; nx = cnt > 0u ? cnt : 1u;
}

__device__ __forceinline__ void xcd_barrier(const XcdBarrier& b) {
    asm volatile("s_waitcnt vmcnt(0)" ::: "memory");
    __syncthreads();
    if (threadIdx.x == 0) {
        unsigned* bar = b.bar;
        __builtin_amdgcn_s_waitcnt(0);
        unsigned nloc = b.st[0], nx = b.st[1];
        if (nloc == 0u) { xcd_barrier_complete(bar, b.x, nloc, nx); b.st[0] = nloc; b.st[1] = nx; }
        const unsigned old = xb_add(&bar[XB_XSUB(b.x)], 1u);
        const unsigned gen = old / nloc;
        if (old + 1u == (gen + 1u) * nloc) {
            __builtin_amdgcn_fence(__ATOMIC_RELEASE, "agent");
            asm volatile("s_waitcnt vmcnt(0)" ::: "memory");
            const unsigned og = xb_add(&bar[XB_TOP], 1u);
            const unsigned tg = og / nx;
            if (og + 1u == (tg + 1u) * nx) xb_add(&bar[XB_TOPGEN], 1u);
            else XB_SPIN(xb_ld(&bar[XB_TOPGEN]) == tg, bar);
            __builtin_amdgcn_fence(__ATOMIC_ACQUIRE, "agent");
            xb_add(&bar[XB_XGEN(b.x)], 1u);
            asm volatile("s_waitcnt vmcnt(0)" ::: "memory");
        } else {
            XB_SPIN(xb_ld(&bar[XB_XGEN(b.x)]) == gen, bar);
            __builtin_amdgcn_fence(__ATOMIC_ACQUIRE, "agent");
            asm volatile("s_waitcnt vmcnt(0)" ::: "memory");
        }
    }
    __syncthreads();
}
constexpr int NWAVES = 8;
#ifndef MK_ONE_LAUNCH
#define MK_ONE_LAUNCH 1
#endif
constexpr int N_PHASES = 6;
constexpr int BATCH = 4, SEQ = 4096, DMODEL = 2048, M = BATCH * SEQ, IN_W = 5952, N1 = 6144, QRANK = 512, KVRANK = 256, NQ = 1536, NKV = 2048;
constexpr size_t MiB = 1u << 20;
constexpr size_t WS_CTL = 0, CTL_ZERO_BYTES = 1 * MiB;
constexpr size_t WS_WIN = 2 * MiB, WS_WQB = 26 * MiB, WS_WKVB = 28 * MiB, WS_WOUT = 30 * MiB, WS_TRIG = 38 * MiB, WS_STATS = 42 * MiB, WS_YSTAT = 43 * MiB;
constexpr size_t WS_XN = 48 * MiB, WS_QL = 112 * MiB, WS_KVL = 128 * MiB, WS_KR = 136 * MiB, WS_GM = 138 * MiB, WS_GD = 170 * MiB, WS_DQ = 202 * MiB, WS_DK = 234 * MiB, WS_DV = 266 * MiB;
constexpr size_t WS_QM = 298 * MiB, WS_KVM = 346 * MiB, WS_MIX = 410 * MiB, WS_PARK = 474 * MiB, WS_END = 506 * MiB;
constexpr int CW_BAR = 4096;
constexpr int RING_OFF = 0, RING_BYTES = 131072, LDSCTL_OFF = RING_BYTES, MISC_OFF = LDSCTL_OFF + 320, LDS_BYTES = 147456;
static_assert(att::ATT_LDS_BYTES <= RING_BYTES, "attention scratch fits the ring region");

struct Args { const void* in[15]; float* out; unsigned char* ws; float freq[32]; int ph_lo, ph_hi; };

__device__ __forceinline__ float wave_sum(float v) {
#pragma unroll
    for (int o = 1; o < 64; o <<= 1) v += __shfl_xor(v, o);
    return v;
}
template <class MapN>
__device__ __forceinline__ void transpose_item(const float* W, int K, int N, bf16* WT, const float* kscale, MapN mapn, LAS float* scr, int item, int lane) {
    const int nblk = N / 32, kb = item / nblk, nb = item % nblk, k0 = 64 * kb, n0 = 32 * nb;
#pragma unroll 8
    for (int i = 0; i < 32; ++i) { const int kk = 2 * i + (lane >> 5); float v = W[(size_t)(k0 + kk) * N + n0 + (lane & 31)]; if (kscale) v *= kscale[k0 + kk]; scr[kk * 33 + (lane & 31)] = v; }
    LDS_WAIT(); asm volatile("" ::: "memory");
    const int c = lane & 7;
#pragma unroll
    for (int j = 0; j < 4; ++j) { const int n = (lane >> 3) + 8 * j; const LAS float* s = scr + (8 * c) * 33 + n;
        v4u o; o.x = pk2(s[0 * 33], s[1 * 33]); o.y = pk2(s[2 * 33], s[3 * 33]); o.z = pk2(s[4 * 33], s[5 * 33]); o.w = pk2(s[6 * 33], s[7 * 33]);
        *(GAS v4u*)(WT + (size_t)mapn(n0 + n) * K + k0 + 8 * c) = o; }
    LDS_WAIT(); asm volatile("" ::: "memory");
}
struct MapWin { __device__ __forceinline__ int operator()(int n) const { if (n < 768) return n; if (n < 832) { const int i = n - 768; return 768 + (i < 32 ? 2 * i : 2 * (i - 32) + 1); } return n + 192; } };
struct MapWqb { __device__ __forceinline__ int operator()(int n) const { const int h = n / 192, d = n - h * 192; if (d < 128) return n; const int i = d - 128; return h * 192 + 128 + (i < 32 ? 2 * i : 2 * (i - 32) + 1); } };
struct MapId  { __device__ __forceinline__ int operator()(int n) const { return n; } };

__global__ void __launch_bounds__(NWAVES * 64, 2) fwd_kernel(Args args) {
    extern __shared__ __attribute__((aligned(16))) unsigned char lds_raw[];
    LAS unsigned char* lds = (LAS unsigned char*)lds_raw;
    volatile LAS unsigned* MISC = (volatile LAS unsigned*)(lds + MISC_OFF);
    const int tid = threadIdx.x, lane = tid & 63, wave = __builtin_amdgcn_readfirstlane(tid >> 6);
    const int G = gridDim.x; const int bx = blockIdx.x; const int vcu = (G % 8 == 0) ? (bx % 8) * (G / 8) + bx / 8 : bx;
    unsigned char* ws = args.ws;
    gu32* ctl = (gu32*)(ws + WS_CTL);
    const float* x = (const float*)args.in[0]; const int* positions = (const int*)args.in[1]; const float* g_pre = (const float*)args.in[2]; const float* w_in = (const float*)args.in[3];
    const float* g_q_a = (const float*)args.in[4]; const float* w_q_b = (const float*)args.in[5]; const float* g_kv_a = (const float*)args.in[6]; const float* w_kv_b = (const float*)args.in[7];
    const float* lq1 = (const float*)args.in[8]; const float* lk1 = (const float*)args.in[9]; const float* lq2 = (const float*)args.in[10]; const float* lk2 = (const float*)args.in[11];
    const float* g_sub = (const float*)args.in[12]; const float* w_out = (const float*)args.in[13]; const float* g_post = (const float*)args.in[14];
    float* out = args.out;
    bf16* WinT = (bf16*)(ws + WS_WIN); bf16* WqbT = (bf16*)(ws + WS_WQB); bf16* WkvbT = (bf16*)(ws + WS_WKVB); bf16* WoutT = (bf16*)(ws + WS_WOUT);
    float* TRIG = (float*)(ws + WS_TRIG); float* STATS = (float*)(ws + WS_STATS); float* YSTAT = (float*)(ws + WS_YSTAT);
    bf16* XN = (bf16*)(ws + WS_XN); bf16* QL = (bf16*)(ws + WS_QL); bf16* KVL = (bf16*)(ws + WS_KVL); bf16* KR = (bf16*)(ws + WS_KR);
    bf16* GM = (bf16*)(ws + WS_GM); bf16* GD = (bf16*)(ws + WS_GD); bf16* DQ = (bf16*)(ws + WS_DQ); bf16* DK = (bf16*)(ws + WS_DK); bf16* DV = (bf16*)(ws + WS_DV);
    bf16* QM = (bf16*)(ws + WS_QM); bf16* KVM = (bf16*)(ws + WS_KVM); bf16* MIX = (bf16*)(ws + WS_MIX); float* PARK = (float*)(ws + WS_PARK);

    for (int u = tid; u < (LDS_BYTES - LDSCTL_OFF) / 4; u += NWAVES * 64) ((LAS unsigned*)(lds + LDSCTL_OFF))[u] = 0u;
    __syncthreads();
    XcdBarrier bar; bar.bar = (unsigned*)(ctl + CW_BAR); bar.x = 0; bar.st = nullptr;
#if MK_ONE_LAUNCH
    bar = xcd_barrier_post((unsigned*)(ctl + CW_BAR), MISC + 8);
#define GRID_BAR() xcd_barrier(bar)
#else
#define GRID_BAR() do {} while (0)
#endif
    const int lo = args.ph_lo, hi_ = args.ph_hi;
#ifndef PH_MASK
#define PH_MASK 63
#endif
#define IN(k) (((PH_MASK >> (k)) & 1) && lo <= (k) && (k) < hi_)
#define BOTH(k) (IN(k) && IN((k) + 1))
#ifndef REP_MASK
#define REP_MASK 0
#endif
#define REPS(k) ((((REP_MASK) >> (k)) & 1) ? 2 : 1)
    const int gw = vcu * NWAVES + wave, NGW = G * NWAVES;

    if (IN(0)) {
        LAS float* scr = (LAS float*)(lds + RING_OFF + wave * 16384);
        constexpr int I_IN = (DMODEL / 64) * (IN_W / 32), I_QB = (QRANK / 64) * (NQ / 32), I_KVB = (KVRANK / 64) * (NKV / 32), I_OUT = (DMODEL / 64) * (DMODEL / 32);
        constexpr int NITEMS = I_IN + I_QB + I_KVB + I_OUT;
        for (int it = gw; it < NITEMS; it += NGW) {
            int r = it;
            if (r < I_IN) { transpose_item(w_in, DMODEL, IN_W, WinT, nullptr, MapWin(), scr, r, lane); continue; } r -= I_IN;
            if (r < I_QB) { transpose_item(w_q_b, QRANK, NQ, WqbT, g_q_a, MapWqb(), scr, r, lane); continue; } r -= I_QB;
            if (r < I_KVB) { transpose_item(w_kv_b, KVRANK, NKV, WkvbT, g_kv_a, MapId(), scr, r, lane); continue; } r -= I_KVB;
            transpose_item(w_out, DMODEL, DMODEL, WoutT, nullptr, MapId(), scr, r, lane);
        }
        for (int i = gw * 64 + lane; i < 192 * 256; i += NGW * 64) *(GAS v4u*)(WinT + (size_t)832 * DMODEL + (size_t)i * 8) = (v4u){0u, 0u, 0u, 0u};
        {
            f32x4 gp[8];
#pragma unroll
            for (int j = 0; j < 8; ++j) gp[j] = ((const GAS f32x4*)g_pre)[64 * j + lane];
            for (int m = gw; m < M; m += NGW) {
                const GAS f32x4* xr = (const GAS f32x4*)(x + (size_t)m * DMODEL) + lane; f32x4 v[8]; float s = 0.f;
#pragma unroll
                for (int j = 0; j < 8; ++j) { v[j] = xr[64 * j]; s += (v[j].x * v[j].x + v[j].y * v[j].y) + (v[j].z * v[j].z + v[j].w * v[j].w); }
                const float rstd = 1.0f / sqrtf(wave_sum(s) * (1.0f / DMODEL) + 1e-6f);
                GAS unsigned long long* o8 = (GAS unsigned long long*)(XN + (size_t)m * DMODEL) + lane;
#pragma unroll
                for (int j = 0; j < 8; ++j) { const f32x4 w = v[j] * rstd * gp[j]; o8[64 * j] = (unsigned long long)pk2(w.x, w.y) | ((unsigned long long)pk2(w.z, w.w) << 32); }
            }
        }
        for (int idx = gw * 64 + lane; idx < M * 32; idx += NGW * 64) {
            const int m = idx >> 5, i = idx & 31;
            const float ang = (float)positions[m] * args.freq[i];
            double f = (double)ang * 0.15915494309189535; f -= __builtin_rint(f);
            const double q = __builtin_rint(f * 4.0); const double t = (f - q * 0.25) * 6.283185307179586; const double t2 = t * t;
            const double sn = t * (1.0 + t2 * (-1.0 / 6 + t2 * (1.0 / 120 + t2 * (-1.0 / 5040 + t2 * (1.0 / 362880 + t2 * (-1.0 / 39916800 + t2 * (1.0 / 6227020800.0)))))));
            const double cs = 1.0 + t2 * (-0.5 + t2 * (1.0 / 24 + t2 * (-1.0 / 720 + t2 * (1.0 / 40320 + t2 * (-1.0 / 3628800 + t2 * (1.0 / 479001600.0 + t2 * (-1.0 / 87178291200.0)))))));
            const int qi = ((int)q) & 3; double s_, c_;
            if (qi == 0) { s_ = sn; c_ = cs; } else if (qi == 1) { s_ = cs; c_ = -sn; } else if (qi == 2) { s_ = -sn; c_ = -cs; } else { s_ = -cs; c_ = sn; }
            TRIG[(size_t)m * 64 + i] = (float)c_; TRIG[(size_t)m * 64 + 32 + i] = (float)s_;
        }
        if (BOTH(0)) GRID_BAR();
    }

    if (IN(1)) {
        pg8::Gemm g{XN, WinT, M, N1, DMODEL}; pg8::StaticOrder S; S.init(M, N1, G, bx);
        pg8::EpiProj E{QL, KVL, KR, GM, GD, DQ, DK, DV, STATS, TRIG};
        pg8::gemm_phase<pg8::EpiProj, pg8::StaticOrder, true, true>(lds + RING_OFF, g, S, E);
        if (BOTH(1)) GRID_BAR();
    }

    if (IN(2)) {
        { pg8::Gemm g{QL, WqbT, M, NQ, QRANK}; pg8::StaticOrder S; S.init(M, NQ, G, bx);
          pg8::EpiQ E{QM, STATS, TRIG};
          pg8::gemm_phase<pg8::EpiQ, pg8::StaticOrder, true, true>(lds + RING_OFF, g, S, E); }
        { pg8::Gemm g{KVL, WkvbT, M, NKV, KVRANK}; pg8::StaticOrder S; S.init(M, NKV, G, bx);
          pg8::EpiKV E{KVM, STATS};
          pg8::gemm_phase<pg8::EpiKV, pg8::StaticOrder, true, true>(lds + RING_OFF, g, S, E); }
        if (BOTH(2)) GRID_BAR();
    }

    if (IN(3)) {
        float lam;
        { const float a = wave_sum(lq1[lane] * lk1[lane]), b2 = wave_sum(lq2[lane] * lk2[lane]); lam = expf(a) - expf(b2) + 0.2f; }
        const att::Ptrs P{QM, KVM, KR, DQ, DK, DV, GM, GD, MIX, positions, g_sub};
        LAS char* al = (LAS char*)(lds + RING_OFF);
        for (int it = vcu; it < 256; it += G) {
            const int bh = it >> 3, s = it & 7, b = bh >> 3, h = bh & 7;
            #ifndef REP_MLA
#define REP_MLA 0
#endif
#ifndef REP_DIFF
#define REP_DIFF 0
#endif
#ifndef NO_MLA
            for (int q = 0; q <= REP_MLA; ++q) { att::mla_unit(P, b, h, s, al); att::mla_unit(P, b, h, 15 - s, al); }
#endif
#ifndef NO_DIFF
            for (int q = 0; q <= REP_DIFF; ++q) {
            att::diff_unit(P, b, h, s, al, lam, PARK + (size_t)(bx * NWAVES + wave) * 4096); att::diff_unit(P, b, h, 15 - s, al, lam, PARK + (size_t)(bx * NWAVES + wave) * 4096); }
#endif
        }
        if (BOTH(3)) GRID_BAR();
    }

    if (IN(4)) {
        pg8::Gemm g{MIX, WoutT, M, DMODEL, DMODEL}; pg8::StaticOrder S; S.init(M, DMODEL, G, bx);
        pg8::EpiY E{out, YSTAT};
        pg8::gemm_phase<pg8::EpiY, pg8::StaticOrder, true, true>(lds + RING_OFF, g, S, E);
        if (BOTH(4)) GRID_BAR();
    }

    if (IN(5)) {
        f32x4 gp[8];
#pragma unroll
        for (int j = 0; j < 8; ++j) gp[j] = ((const GAS f32x4*)g_post)[64 * j + lane];
        for (int m = gw; m < M; m += NGW) {
            const GAS f32x4* xr = (const GAS f32x4*)(x + (size_t)m * DMODEL) + lane; GAS f32x4* yr = (GAS f32x4*)(out + (size_t)m * DMODEL) + lane;
            const float ss = wave_sum(lane < 32 ? YSTAT[(size_t)m * 32 + lane] : 0.f);
            const float rstd = 1.0f / sqrtf(ss * (1.0f / DMODEL) + 1e-6f);
#pragma unroll
            for (int j = 0; j < 8; ++j) { const f32x4 y = yr[64 * j], xv = xr[64 * j]; yr[64 * j] = xv + y * rstd * gp[j]; }
        }
    }
#undef IN
#undef BOTH
}

extern "C" void kernel_launch(void* const* d_in, const int* in_sizes, int n_in, void* d_out, int out_size, void* d_ws, size_t ws_size, hipStream_t stream) {
    static int grid = 0;
    if (grid == 0) {
        if (n_in != 15 || in_sizes[0] != M * DMODEL || out_size != M * DMODEL || ws_size < WS_END) { fprintf(stderr, "kernel_launch: unexpected shapes (n_in %d, in0 %d, out %d, ws %zu)\n", n_in, n_in > 0 ? in_sizes[0] : -1, out_size, ws_size); grid = -1; return; }
        int dev = 0, cus = 0, per_cu = 0;
        if (hipGetDevice(&dev) != hipSuccess || hipDeviceGetAttribute(&cus, hipDeviceAttributeMultiprocessorCount, dev) != hipSuccess) { grid = -1; return; }
        if (hipFuncSetAttribute((const void*)fwd_kernel, hipFuncAttributeMaxDynamicSharedMemorySize, LDS_BYTES) != hipSuccess) { fprintf(stderr, "kernel_launch: hipFuncSetAttribute failed\n"); grid = -1; return; }
        if (hipOccupancyMaxActiveBlocksPerMultiprocessor(&per_cu, (const void*)fwd_kernel, NWAVES * 64, LDS_BYTES) != hipSuccess || per_cu < 1) fprintf(stderr, "kernel_launch: occupancy query reports %d blocks/CU\n", per_cu);
        (void)hipGetLastError();
        grid = cus > 256 ? 256 : cus;
    }
    if (grid < 0) return;
    if (hipMemsetAsync((char*)d_ws + WS_CTL, 0, CTL_ZERO_BYTES, stream) != hipSuccess) { fprintf(stderr, "kernel_launch: memset failed\n"); return; }
    Args a{};
    for (int i = 0; i < 15; ++i) a.in[i] = d_in[i];
    a.out = (float*)d_out; a.ws = (unsigned char*)d_ws;
    for (int i = 0; i < 32; ++i) a.freq[i] = 1.0f / powf(10000.0f, (float)(2 * i) / 64.0f);
#if MK_ONE_LAUNCH
    a.ph_lo = 0; a.ph_hi = N_PHASES;
    hipLaunchKernelGGL(fwd_kernel, dim3(grid), dim3(NWAVES * 64), LDS_BYTES, stream, a);
#else
    for (int p = 0; p < N_PHASES; ++p) for (int rep = 0; rep < REPS(p); ++rep) { a.ph_lo = p; a.ph_hi = p + 1; hipLaunchKernelGGL(fwd_kernel, dim3(grid), dim3(NWAVES * 64), LDS_BYTES, stream, a); }
#endif
    const hipError_t le = hipPeekAtLastError();
    if (le != hipSuccess) fprintf(stderr, "kernel_launch: launch failed: %s\n", hipGetErrorName(le));
}
```
